# Optimizing an MI355X kernel written in HIP

```python
import jax
import jax.numpy as jnp
from jax import lax
import numpy as np

D_MODEL = 1024
BATCH = 8
SEQ = 2048
DEPTH = 4

N_MIXERS = 3
N_HEADS = 16
HEAD_DIM = 64
D_FF = 4 * D_MODEL
ROPE_THETA = 10000.0
NORM_EPS = 1e-6
NEG_INF = -1e30
POS_BIG = 1e30

QKV_COLS = 3 * N_HEADS * HEAD_DIM

MOBA_BLOCK = 256
MOBA_TOPK = 3
MOBA_Q_CHUNK = 16

SB_Q_BLOCK = 128

NSA_KV_GROUPS = 4
NSA_HEADS_PER_GROUP = N_HEADS // NSA_KV_GROUPS
NSA_CMP_BLOCK = 32
NSA_CMP_STRIDE = 16
NSA_CMP_HIDDEN = 256
NSA_SLC_BLOCK = 64
NSA_SLC_TOPN = 16
NSA_SLC_Q_CHUNK = 32
NSA_WINDOW = 512
NSA_WIN_Q_BLOCK = 128
NSA_KV_COLS = NSA_KV_GROUPS * HEAD_DIM
NSA_IN_COLS = N_HEADS * HEAD_DIM + 6 * NSA_KV_COLS + 3 * N_HEADS

kernel_name = 'hybrid_moba_stickbreak_nsa_trunk'


def rms_norm(x, g):
    xf = x.astype(jnp.float32)
    y = xf * lax.rsqrt(jnp.mean(xf * xf, axis=-1, keepdims=True) + NORM_EPS)
    return (y * g.astype(jnp.float32)).astype(x.dtype)


def rope_tables(seq_len, dtype):
    inv_freq = 1.0 / (ROPE_THETA ** (jnp.arange(0, HEAD_DIM, 2, dtype=jnp.float32) / HEAD_DIM))
    ang = jnp.arange(seq_len, dtype=jnp.float32)[:, None] * inv_freq[None, :]
    return jnp.cos(ang).astype(dtype), jnp.sin(ang).astype(dtype)


def apply_rope(t, cos, sin):
    t1, t2 = jnp.split(t, 2, axis=-1)
    return jnp.concatenate([t1 * cos - t2 * sin, t1 * sin + t2 * cos], axis=-1)


def to_heads(t, n):
    B, S, _ = t.shape
    return t.reshape(B, S, n, HEAD_DIM).transpose(0, 2, 1, 3)


def merge_heads(o):
    B, H, S, Dh = o.shape
    return o.transpose(0, 2, 1, 3).reshape(B, S, H * Dh)


def gather_blocks(blocks, idx):
    return jax.vmap(jax.vmap(lambda b_, i_: b_[i_]))(blocks, idx)


def moba_attention(q, k, v):
    B, H, S, Dh = q.shape
    scale = Dh ** -0.5
    nb = -(-S // MOBA_BLOCK)
    pad = nb * MOBA_BLOCK - S
    kb = jnp.pad(k, ((0, 0), (0, 0), (0, pad), (0, 0))).reshape(B, H, nb, MOBA_BLOCK, Dh)
    vb = jnp.pad(v, ((0, 0), (0, 0), (0, pad), (0, 0))).reshape(B, H, nb, MOBA_BLOCK, Dh)
    k_mean = jnp.mean(kb.astype(jnp.float32), axis=3)
    gate = jnp.einsum('bhsd,bhnd->bhsn', q.astype(jnp.float32), k_mean)
    q_blk = jnp.arange(S) // MOBA_BLOCK
    past = jnp.arange(nb)[None, :] < q_blk[:, None]
    gate = jnp.where(past, gate, NEG_INF)
    n_top = min(MOBA_TOPK, nb)
    _, sel = lax.top_k(gate, n_top)
    sel_valid = jnp.arange(n_top)[None, :] < jnp.minimum(q_blk, n_top)[:, None]
    qc_len = MOBA_Q_CHUNK

    def chunk(c):
        t0 = c * qc_len
        qc = lax.dynamic_slice_in_dim(q, t0, qc_len, axis=2)
        ic = lax.dynamic_slice_in_dim(sel, t0, qc_len, axis=2)
        mc = lax.dynamic_slice_in_dim(sel_valid, t0, qc_len, axis=0)
        k_sel = gather_blocks(kb, ic)
        v_sel = gather_blocks(vb, ic)
        s_sel = jnp.einsum('bhqd,bhqjkd->bhqjk', qc, k_sel).astype(jnp.float32) * scale
        s_sel = jnp.where(mc[None, None, :, :, None], s_sel, NEG_INF).reshape(B, H, qc_len, n_top * MOBA_BLOCK)
        own = t0 // MOBA_BLOCK
        k_own = lax.dynamic_index_in_dim(kb, own, axis=2, keepdims=False)
        v_own = lax.dynamic_index_in_dim(vb, own, axis=2, keepdims=False)
        s_own = jnp.einsum('bhqd,bhkd->bhqk', qc, k_own).astype(jnp.float32) * scale
        t = t0 + jnp.arange(qc_len)
        kpos = own * MOBA_BLOCK + jnp.arange(MOBA_BLOCK)
        s_own = jnp.where(kpos[None, :] <= t[:, None], s_own, NEG_INF)
        p = jax.nn.softmax(jnp.concatenate([s_own, s_sel], axis=-1), axis=-1)
        p_own = p[..., :MOBA_BLOCK].astype(v.dtype)
        p_sel = p[..., MOBA_BLOCK:].reshape(B, H, qc_len, n_top, MOBA_BLOCK).astype(v.dtype)
        return (jnp.einsum('bhqk,bhkd->bhqd', p_own, v_own)
                + jnp.einsum('bhqjk,bhqjkd->bhqd', p_sel, v_sel))

    out = lax.map(chunk, jnp.arange(S // qc_len))
    return out.transpose(1, 2, 0, 3, 4).reshape(B, H, S, Dh)


def moba_mixer(h, w_in, w_out, cos, sin):
    q, k, v = jnp.split(h @ w_in, 3, axis=-1)
    q = apply_rope(to_heads(q, N_HEADS), cos, sin)
    k = apply_rope(to_heads(k, N_HEADS), cos, sin)
    v = to_heads(v, N_HEADS)
    return merge_heads(moba_attention(q, k, v)) @ w_out


def stick_breaking_attention(q, k, v):
    B, H, S, Dh = q.shape
    scale = Dh ** -0.5
    s_pos = jnp.arange(S)

    def block(i):
        t0 = i * SB_Q_BLOCK
        qb = lax.dynamic_slice_in_dim(q, t0, SB_Q_BLOCK, axis=2)
        z = jnp.einsum('bhqd,bhkd->bhqk', qb, k).astype(jnp.float32) * scale
        t = t0 + jnp.arange(SB_Q_BLOCK)
        causal = s_pos[None, :] < t[:, None]
        log_beta = jax.nn.log_sigmoid(z)
        log_1m = jnp.where(causal, jax.nn.log_sigmoid(-z), 0.0)
        log_1m_next = jnp.concatenate([log_1m[..., 1:], jnp.zeros_like(log_1m[..., :1])], axis=-1)
        suffix = lax.cumsum(log_1m_next, axis=log_1m_next.ndim - 1, reverse=True)
        w = jnp.where(causal, jnp.exp(log_beta + suffix), 0.0)
        return jnp.einsum('bhqk,bhkd->bhqd', w.astype(v.dtype), v)

    out = lax.map(block, jnp.arange(S // SB_Q_BLOCK))
    return out.transpose(1, 2, 0, 3, 4).reshape(B, H, S, Dh)


def stick_breaking_mixer(h, w_in, w_out):
    q, k, v = jnp.split(h @ w_in, 3, axis=-1)
    o = stick_breaking_attention(to_heads(q, N_HEADS), to_heads(k, N_HEADS), to_heads(v, N_HEADS))
    return merge_heads(o) @ w_out


def nsa_compress(t, pos_emb, w1, w2):
    S = t.shape[2]
    n_cmp = (S - NSA_CMP_BLOCK) // NSA_CMP_STRIDE + 1
    idx = jnp.arange(n_cmp)[:, None] * NSA_CMP_STRIDE + jnp.arange(NSA_CMP_BLOCK)[None, :]
    blocks = t[:, :, idx, :] + pos_emb
    flat = blocks.reshape(blocks.shape[:3] + (NSA_CMP_BLOCK * HEAD_DIM,))
    return jax.nn.gelu(flat @ w1) @ w2


def nsa_compressed_branch(q, kc, vc):
    S = q.shape[3]
    n_cmp = kc.shape[2]
    s = jnp.einsum('bgnsd,bgcd->bgnsc', q, kc).astype(jnp.float32) * (HEAD_DIM ** -0.5)
    blk_end = jnp.arange(n_cmp) * NSA_CMP_STRIDE + NSA_CMP_BLOCK - 1
    valid = blk_end[None, :] <= jnp.arange(S)[:, None]
    p = jnp.where(valid, jax.nn.softmax(jnp.where(valid, s, NEG_INF), axis=-1), 0.0)
    return jnp.einsum('bgnsc,bgcd->bgnsd', p.astype(vc.dtype), vc), p


def nsa_selected_branch(q, ks, vs, p_cmp):
    B, G, Hg, S, Dh = q.shape
    n_cmp = p_cmp.shape[-1]
    n_sel = S // NSA_SLC_BLOCK
    c_start = np.arange(n_cmp) * NSA_CMP_STRIDE
    s_start = np.arange(n_sel) * NSA_SLC_BLOCK
    lo = np.maximum(c_start[:, None], s_start[None, :])
    hi = np.minimum(c_start[:, None] + NSA_CMP_BLOCK, s_start[None, :] + NSA_SLC_BLOCK)
    overlap = jnp.asarray(np.clip(hi - lo, 0, None) / NSA_CMP_BLOCK, dtype=jnp.float32)
    imp = jnp.einsum('bgnsc,cj->bgsj', p_cmp, overlap)
    q_blk = jnp.arange(S) // NSA_SLC_BLOCK
    j = jnp.arange(n_sel)[None, :]
    forced = (j == 0) | (j == q_blk[:, None]) | (j == q_blk[:, None] - 1)
    score = jnp.where(j <= q_blk[:, None], jnp.where(forced, POS_BIG, imp), NEG_INF)
    n_top = min(NSA_SLC_TOPN, n_sel)
    top_val, top_idx = lax.top_k(score, n_top)
    slot_valid = top_val > 0.5 * NEG_INF
    kb = ks.reshape(B, G, n_sel, NSA_SLC_BLOCK, Dh)
    vb = vs.reshape(B, G, n_sel, NSA_SLC_BLOCK, Dh)
    qc_len = NSA_SLC_Q_CHUNK

    def chunk(c):
        t0 = c * qc_len
        qc = lax.dynamic_slice_in_dim(q, t0, qc_len, axis=3)
        ic = lax.dynamic_slice_in_dim(top_idx, t0, qc_len, axis=2)
        mc = lax.dynamic_slice_in_dim(slot_valid, t0, qc_len, axis=2)
        k_sel = gather_blocks(kb, ic)
        v_sel = gather_blocks(vb, ic)
        s = jnp.einsum('bgnqd,bgqjkd->bgnqjk', qc, k_sel).astype(jnp.float32) * (Dh ** -0.5)
        kpos = ic[..., None] * NSA_SLC_BLOCK + jnp.arange(NSA_SLC_BLOCK)
        t = t0 + jnp.arange(qc_len)
        ok = mc[..., None] & (kpos <= t[None, None, :, None, None])
        s = jnp.where(ok[:, :, None], s, NEG_INF).reshape(B, G, Hg, qc_len, n_top * NSA_SLC_BLOCK)
        p = jax.nn.softmax(s, axis=-1).reshape(B, G, Hg, qc_len, n_top, NSA_SLC_BLOCK)
        return jnp.einsum('bgnqjk,bgqjkd->bgnqd', p.astype(vs.dtype), v_sel)

    out = lax.map(chunk, jnp.arange(S // qc_len))
    return out.transpose(1, 2, 3, 0, 4, 5).reshape(B, G, Hg, S, Dh)


def nsa_window_branch(q, kw, vw):
    B, G, Hg, S, Dh = q.shape
    W, Qb = NSA_WINDOW, NSA_WIN_Q_BLOCK
    kp = jnp.pad(kw, ((0, 0), (0, 0), (W, 0), (0, 0)))
    vp = jnp.pad(vw, ((0, 0), (0, 0), (W, 0), (0, 0)))

    def block(i):
        t0 = i * Qb
        qb = lax.dynamic_slice_in_dim(q, t0, Qb, axis=3)
        kb = lax.dynamic_slice_in_dim(kp, t0, W + Qb, axis=2)
        vb = lax.dynamic_slice_in_dim(vp, t0, W + Qb, axis=2)
        s = jnp.einsum('bgnqd,bgkd->bgnqk', qb, kb).astype(jnp.float32) * (Dh ** -0.5)
        t = t0 + jnp.arange(Qb)
        kpos = t0 - W + jnp.arange(W + Qb)
        diff = t[:, None] - kpos[None, :]
        ok = (diff >= 0) & (diff < W) & (kpos[None, :] >= 0)
        p = jax.nn.softmax(jnp.where(ok, s, NEG_INF), axis=-1)
        return jnp.einsum('bgnqk,bgkd->bgnqd', p.astype(vw.dtype), vb)

    out = lax.map(block, jnp.arange(S // Qb))
    return out.transpose(1, 2, 3, 0, 4, 5).reshape(B, G, Hg, S, Dh)


def nsa_mixer(h, w_in, pos_k, w1_k, w2_k, pos_v, w1_v, w2_v, w_out, cos, sin):
    B, S, _ = h.shape
    G, Hg = NSA_KV_GROUPS, NSA_HEADS_PER_GROUP
    sizes = [N_HEADS * HEAD_DIM] + [NSA_KV_COLS] * 6 + [3 * N_HEADS]
    q, kc, vc, ks, vs, kw, vw, g = jnp.split(h @ w_in, np.cumsum(sizes)[:-1].tolist(), axis=-1)
    q = apply_rope(to_heads(q, N_HEADS), cos, sin).reshape(B, G, Hg, S, HEAD_DIM)
    kc = apply_rope(to_heads(kc, G), cos, sin)
    ks = apply_rope(to_heads(ks, G), cos, sin)
    kw = apply_rope(to_heads(kw, G), cos, sin)
    vc, vs, vw = to_heads(vc, G), to_heads(vs, G), to_heads(vw, G)
    k_cmp = nsa_compress(kc, pos_k, w1_k, w2_k)
    v_cmp = nsa_compress(vc, pos_v, w1_v, w2_v)
    o_cmp, p_cmp = nsa_compressed_branch(q, k_cmp, v_cmp)
    o_slc = nsa_selected_branch(q, ks, vs, p_cmp)
    o_win = nsa_window_branch(q, kw, vw)
    gates = jax.nn.sigmoid(g.astype(jnp.float32)).reshape(B, S, G, Hg, 3)
    gates = gates.transpose(0, 2, 3, 1, 4).astype(q.dtype)
    o = gates[..., 0:1] * o_cmp + gates[..., 1:2] * o_slc + gates[..., 2:3] * o_win
    return merge_heads(o.reshape(B, N_HEADS, S, HEAD_DIM)) @ w_out


def squared_relu_mlp(h, w_up, w_down):
    return jnp.square(jax.nn.relu(h @ w_up)) @ w_down


def setup_inputs(seed: int = 0) -> dict:
    key = jax.random.key(seed)
    keys = iter(jax.random.split(key, 64))

    def nrm(shape, scale):
        return scale * jax.random.normal(next(keys), shape, jnp.float32)

    def gain():
        return 1.0 + 0.05 * jax.random.normal(next(keys), (D_MODEL,), jnp.float32)

    p = {'x': jax.random.normal(next(keys), (BATCH, SEQ, D_MODEL), jnp.float32)}
    for i in range(DEPTH):
        kind = i % N_MIXERS
        cols = NSA_IN_COLS if kind == 2 else QKV_COLS
        p[f'l{i}_ln_mix_pre'] = gain()
        p[f'l{i}_w_in'] = nrm((D_MODEL, cols), D_MODEL ** -0.5)
        if kind == 2:
            for kv in ('k', 'v'):
                p[f'l{i}_cmp_pos_{kv}'] = nrm((NSA_CMP_BLOCK, HEAD_DIM), 0.1)
                p[f'l{i}_cmp_w1_{kv}'] = nrm((NSA_CMP_BLOCK * HEAD_DIM, NSA_CMP_HIDDEN), (NSA_CMP_BLOCK * HEAD_DIM) ** -0.5)
                p[f'l{i}_cmp_w2_{kv}'] = nrm((NSA_CMP_HIDDEN, HEAD_DIM), NSA_CMP_HIDDEN ** -0.5)
        p[f'l{i}_w_out'] = nrm((N_HEADS * HEAD_DIM, D_MODEL), (N_HEADS * HEAD_DIM) ** -0.5)
        p[f'l{i}_ln_mix_post'] = gain()
        p[f'l{i}_ln_mlp_pre'] = gain()
        p[f'l{i}_w_up'] = nrm((D_MODEL, D_FF), D_MODEL ** -0.5)
        p[f'l{i}_w_down'] = nrm((D_FF, D_MODEL), D_FF ** -0.5)
        p[f'l{i}_ln_mlp_post'] = gain()
    return p


def reference(x,
              l0_ln_mix_pre, l0_w_in, l0_w_out, l0_ln_mix_post, l0_ln_mlp_pre, l0_w_up, l0_w_down, l0_ln_mlp_post,
              l1_ln_mix_pre, l1_w_in, l1_w_out, l1_ln_mix_post, l1_ln_mlp_pre, l1_w_up, l1_w_down, l1_ln_mlp_post,
              l2_ln_mix_pre, l2_w_in, l2_cmp_pos_k, l2_cmp_w1_k, l2_cmp_w2_k, l2_cmp_pos_v, l2_cmp_w1_v, l2_cmp_w2_v,
              l2_w_out, l2_ln_mix_post, l2_ln_mlp_pre, l2_w_up, l2_w_down, l2_ln_mlp_post,
              l3_ln_mix_pre, l3_w_in, l3_w_out, l3_ln_mix_post, l3_ln_mlp_pre, l3_w_up, l3_w_down, l3_ln_mlp_post):
    layers = [
        (l0_ln_mix_pre, (l0_w_in, l0_w_out), l0_ln_mix_post, l0_ln_mlp_pre, l0_w_up, l0_w_down, l0_ln_mlp_post),
        (l1_ln_mix_pre, (l1_w_in, l1_w_out), l1_ln_mix_post, l1_ln_mlp_pre, l1_w_up, l1_w_down, l1_ln_mlp_post),
        (l2_ln_mix_pre, (l2_w_in, l2_cmp_pos_k, l2_cmp_w1_k, l2_cmp_w2_k, l2_cmp_pos_v, l2_cmp_w1_v, l2_cmp_w2_v, l2_w_out),
         l2_ln_mix_post, l2_ln_mlp_pre, l2_w_up, l2_w_down, l2_ln_mlp_post),
        (l3_ln_mix_pre, (l3_w_in, l3_w_out), l3_ln_mix_post, l3_ln_mlp_pre, l3_w_up, l3_w_down, l3_ln_mlp_post),
    ]
    cos, sin = rope_tables(x.shape[1], x.dtype)
    for i in range(DEPTH):
        ln_mix_pre, mix_w, ln_mix_post, ln_mlp_pre, w_up, w_down, ln_mlp_post = layers[i]
        h = rms_norm(x, ln_mix_pre)
        kind = i % N_MIXERS
        if kind == 0:
            m = moba_mixer(h, *mix_w, cos, sin)
        elif kind == 1:
            m = stick_breaking_mixer(h, *mix_w)
        else:
            m = nsa_mixer(h, *mix_w, cos, sin)
        x = x + rms_norm(m, ln_mix_post)
        x = x + rms_norm(squared_relu_mlp(rms_norm(x, ln_mlp_pre), w_up, w_down), ln_mlp_post)
    return x
```

```cpp
#include <hip/hip_runtime.h>
#include <cstdio>
#include <cstdint>
#include <cmath>
namespace pg8 {
#define PG8_LAS __attribute__((address_space(3)))
typedef unsigned short bf16_t;
typedef short bf16x8 __attribute__((ext_vector_type(8)));
typedef float f32x4 __attribute__((ext_vector_type(4)));
typedef unsigned u32x4 __attribute__((ext_vector_type(4)));
constexpr int BM = 256, BK = 64, HALF = 128, HTB = HALF * BK * 2  , STAGE_BYTES = 8 * HTB, NXCD = 8, WGM = 8;

__host__ __device__ __forceinline__ int lds_byte(int r, int c) { const int st = (r >> 4) * 2 + (c >> 5), rr = r & 15, cc = c & 31, ob = rr * 64 + cc * 2; return st * 1024 + (ob ^ (((ob >> 9) & 1) << 5)); }
__host__ __device__ __forceinline__ void stage_rc(int b, int& R, int& C) { const int st = b / 1024, sb = b % 1024, swz = sb ^ (((sb >> 9) & 1) << 5); R = (st >> 1) * 16 + swz / 64; C = (st & 1) * 32 + (swz % 64) / 2; }
__host__ __device__ __forceinline__ int perm32(int rho) { const int n = rho >> 4, i = rho & 15; return 8 * (i >> 2) + 4 * n + (i & 3); }

struct Unit { int pm, pn; };
struct Gemm { const bf16_t* A; const bf16_t* Bt; int M, N, K; };

struct StaticOrder {
    int nM, nN, nwg, G, c;
    __host__ __device__ void init(int M, int N, int G_, int c_) { nM = M / BM; nN = N / BM; nwg = nM * nN; G = G_; c = c_; }
    __host__ __device__ bool next(int i, Unit& u) const {
        const long L = (long)i * G + c; if (L >= nwg) return false;
        int wgid = (int)L; { const int q = nwg / NXCD, r = nwg % NXCD, xcd = wgid % NXCD, off = wgid / NXCD; wgid = (xcd < r ? xcd * (q + 1) : r * (q + 1) + (xcd - r) * q) + off; }
        const int nig = WGM * nN, gid = wgid / nig, fm = gid * WGM, gsz = (nM - fm) < WGM ? (nM - fm) : WGM;
        u.pm = fm + ((wgid % nig) % gsz); u.pn = (wgid % nig) / gsz; return true;
    }
    __device__ __forceinline__ void a_ready(const Unit&) const {}
    __device__ __forceinline__ void done(const Unit&) const {}
};


__device__ __forceinline__ unsigned cvt_pk_bf16(float lo, float hi) { unsigned r; asm volatile("v_cvt_pk_bf16_f32 %0, %1, %2" : "=v"(r) : "v"(lo), "v"(hi)); return r; }

struct EpiBf16 {
    static constexpr bool PERM = true, AFTER_DRAIN = false;
    bf16_t* O; int ldc; int act;
    __device__ __forceinline__ void operator()(const f32x4 (&acc)[2][2][4][2], const Unit& u, int wr, int wc, int fr, int fq) const {
        const int row0 = u.pm * BM + wr * 64 + fr; const int col0 = u.pn * BM + wc * 32 + 8 * fq;
#pragma unroll
        for (int ai = 0; ai < 2; ++ai)
#pragma unroll
            for (int m = 0; m < 4; ++m) { bf16_t* rowp = O + (size_t)(row0 + ai * HALF + m * 16) * ldc + col0;
#pragma unroll
                for (int bj = 0; bj < 2; ++bj) { f32x4 v0 = acc[ai][bj][m][0], v1 = acc[ai][bj][m][1];
                    if (act == 1) {
#pragma unroll
                        for (int e = 0; e < 4; ++e) { const float a = v0[e] > 0.f ? v0[e] : 0.f, b = v1[e] > 0.f ? v1[e] : 0.f; v0[e] = a * a; v1[e] = b * b; } }
                    u32x4 w; w.x = cvt_pk_bf16(v0[0], v0[1]); w.y = cvt_pk_bf16(v0[2], v0[3]); w.z = cvt_pk_bf16(v1[0], v1[1]); w.w = cvt_pk_bf16(v1[2], v1[3]);
                    *(u32x4*)(rowp + bj * HALF) = w; } }
    }
};
template <class Epi, class Sched, bool ALIGN_EPI = false, bool SP2 = false>
__device__ __forceinline__ void gemm_phase(PG8_LAS unsigned char* lds, const Gemm g, const Sched& S, const Epi& E, const int pg8_tid) {
    const int tid = pg8_tid, wid = __builtin_amdgcn_readfirstlane(tid >> 6), lane = tid & 63, wr = wid >> 2, wc = wid & 3, fr = lane & 15, fq = lane >> 4;
    const int K = g.K, nt = K / BK;
    unsigned voffA[2], voffB[2];
#pragma unroll
    for (int i = 0; i < 2; ++i) { int R, C; stage_rc(tid * 16 + i * 8192, R, C); const int Rb = Epi::PERM ? ((R & ~31) + perm32(R & 31)) : R;
        voffA[i] = (unsigned)(R * K + C) * 2u; voffB[i] = (unsigned)(Rb * K + C) * 2u; }
    const size_t kstep = (size_t)(BK * 2);
    const size_t hstep = (size_t)HALF * K * 2;
    const size_t tstep = 2 * hstep;
    const unsigned ldsw = (unsigned)wid * 1024u;
    const int aoff = lds_byte(wr * 64 + fr, fq * 8), boff = lds_byte(wc * 32 + fr, fq * 8);
#define PG8_SA(b, h) (((b) * 2 + (h)) * HTB)
#define PG8_SB(b, h) ((4 + (b) * 2 + (h)) * HTB)
#define PG8_STAGE(bufoff, gbase, voff) do { _Pragma("unroll") for (int _i = 0; _i < 2; ++_i) \
        __builtin_amdgcn_global_load_lds((const unsigned*)((const char*)(gbase) + (voff)[_i]), (PG8_LAS unsigned*)(lds + (bufoff) + ldsw + _i * 8192), 16, 0, 0); } while (0)
#define PG8_LDA(dst, b, h) do { _Pragma("unroll") for (int m = 0; m < 4; ++m) _Pragma("unroll") for (int k = 0; k < 2; ++k) dst[m][k] = *(const PG8_LAS bf16x8*)(lds + PG8_SA(b, h) + aoff + m * 2048 + k * 1024); } while (0)
#define PG8_LDB(dst, b, h) do { _Pragma("unroll") for (int n = 0; n < 2; ++n) _Pragma("unroll") for (int k = 0; k < 2; ++k) dst[n][k] = *(const PG8_LAS bf16x8*)(lds + PG8_SB(b, h) + boff + n * 2048 + k * 1024); } while (0)
#define PG8_MMA(ai, bj, At, Bt) do { __builtin_amdgcn_s_setprio(1); _Pragma("unroll") for (int m = 0; m < 4; ++m) _Pragma("unroll") for (int n = 0; n < 2; ++n) _Pragma("unroll") for (int k = 0; k < 2; ++k) \
        acc[ai][bj][m][n] = __builtin_amdgcn_mfma_f32_16x16x32_bf16(Bt[n][k], At[m][k], acc[ai][bj][m][n], 0, 0, 0); __builtin_amdgcn_s_setprio(0); } while (0)
#define PG8_WAIT_V(n) asm volatile("s_waitcnt vmcnt(" #n ")" ::: "memory")
#define PG8_WAIT_L(n) asm volatile("s_waitcnt lgkmcnt(" #n ")" ::: "memory")
#define PG8_BAR __builtin_amdgcn_s_barrier()
#define PG8_SCHED __builtin_amdgcn_sched_barrier(0)
    Unit cur, nxt; int ui = 0;
    if (!S.next(0, cur)) return;
    f32x4 acc[2][2][4][2];
#pragma unroll
    for (int a = 0; a < 2; ++a)
#pragma unroll
        for (int b = 0; b < 2; ++b)
#pragma unroll
            for (int m = 0; m < 4; ++m)
#pragma unroll
                for (int n = 0; n < 2; ++n) acc[a][b][m][n] = (f32x4){0.f, 0.f, 0.f, 0.f};
    bf16x8 At[4][2], B0[2][2], B1[2][2];
    const char* cA = (const char*)g.A + (size_t)cur.pm * tstep; const char* cB = (const char*)g.Bt + (size_t)cur.pn * tstep;
    S.a_ready(cur);
    if constexpr (SP2) {
        PG8_STAGE(PG8_SB(0, 0), cB, voffB); PG8_STAGE(PG8_SB(0, 1), cB + hstep, voffB); PG8_STAGE(PG8_SA(0, 0), cA, voffA); PG8_STAGE(PG8_SA(0, 1), cA + hstep, voffA);
        if (wr == 1) PG8_BAR;
        PG8_WAIT_V(2); PG8_BAR;
        PG8_STAGE(PG8_SB(1, 0), cB + kstep, voffB); PG8_STAGE(PG8_SA(1, 0), cA + kstep, voffA); PG8_STAGE(PG8_SB(1, 1), cB + hstep + kstep, voffB);
        PG8_WAIT_V(6); PG8_BAR;
    } else {
        PG8_STAGE(PG8_SB(0, 0), cB, voffB); PG8_STAGE(PG8_SA(0, 0), cA, voffA); PG8_STAGE(PG8_SB(0, 1), cB + hstep, voffB); PG8_STAGE(PG8_SA(0, 1), cA + hstep, voffA);
        if (wr == 1) PG8_BAR;
        PG8_WAIT_V(4); PG8_BAR;
        PG8_STAGE(PG8_SB(1, 0), cB + kstep, voffB); PG8_STAGE(PG8_SA(1, 0), cA + kstep, voffA); PG8_STAGE(PG8_SB(1, 1), cB + hstep + kstep, voffB);
        PG8_WAIT_V(6); PG8_BAR;
    }
    for (;;) {
        const bool has_next = S.next(ui + 1, nxt);
        const char* nA = has_next ? (const char*)g.A + (size_t)nxt.pm * tstep : cA; const char* nB = has_next ? (const char*)g.Bt + (size_t)nxt.pn * tstep : cB;
        for (int t = 0; t < nt; t += 2) {
            const bool last = (t == nt - 2);
            const char* a1 = cA + (size_t)(t + 1) * kstep;
            const char* a2 = last ? nA : cA + (size_t)(t + 2) * kstep; const char* b2 = last ? nB : cB + (size_t)(t + 2) * kstep;
            const char* a3 = a2 + kstep; const char* b3 = b2 + kstep;
            if (last && has_next) S.a_ready(nxt);
            if constexpr (SP2) {
            PG8_LDB(B0, 0, 0); PG8_LDB(B1, 0, 1); PG8_SCHED; PG8_LDA(At, 0, 0); PG8_STAGE(PG8_SA(1, 1), a1 + hstep, voffA);
            PG8_WAIT_V(8); PG8_WAIT_L(0); PG8_BAR; PG8_MMA(0, 0, At, B0); PG8_MMA(0, 1, At, B1); PG8_BAR; PG8_SCHED;
            PG8_LDA(At, 0, 1); PG8_STAGE(PG8_SB(0, 0), b2, voffB); PG8_STAGE(PG8_SB(0, 1), b2 + hstep, voffB); PG8_STAGE(PG8_SA(0, 0), a2, voffA);
            PG8_WAIT_V(8); PG8_WAIT_L(0); PG8_BAR; PG8_MMA(1, 0, At, B0); PG8_MMA(1, 1, At, B1); PG8_BAR; PG8_SCHED;
            PG8_LDB(B0, 1, 0); PG8_LDB(B1, 1, 1); PG8_SCHED; PG8_LDA(At, 1, 0); PG8_STAGE(PG8_SA(0, 1), a2 + hstep, voffA);
            PG8_WAIT_V(8); PG8_WAIT_L(0); PG8_BAR; PG8_MMA(0, 0, At, B0); PG8_MMA(0, 1, At, B1); PG8_BAR; PG8_SCHED;
            PG8_LDA(At, 1, 1); PG8_STAGE(PG8_SB(1, 0), b3, voffB); PG8_STAGE(PG8_SB(1, 1), b3 + hstep, voffB); PG8_STAGE(PG8_SA(1, 0), a3, voffA);
            PG8_WAIT_V(8); PG8_WAIT_L(0); PG8_BAR; PG8_MMA(1, 0, At, B0); PG8_MMA(1, 1, At, B1); PG8_BAR; PG8_SCHED;
            } else {
            PG8_LDB(B0, 0, 0); PG8_SCHED; PG8_LDA(At, 0, 0); PG8_STAGE(PG8_SA(1, 1), a1 + hstep, voffA);
            PG8_WAIT_L(8); PG8_BAR; PG8_WAIT_L(0); PG8_MMA(0, 0, At, B0); PG8_BAR; PG8_SCHED;
            PG8_LDB(B1, 0, 1); PG8_STAGE(PG8_SB(0, 0), b2, voffB);
            PG8_BAR; PG8_WAIT_L(0); PG8_MMA(0, 1, At, B1); PG8_BAR;
            PG8_LDA(At, 0, 1); PG8_STAGE(PG8_SA(0, 0), a2, voffA);
            PG8_BAR; PG8_WAIT_L(0); PG8_MMA(1, 0, At, B0); PG8_BAR; PG8_SCHED;
            PG8_STAGE(PG8_SB(0, 1), b2 + hstep, voffB);
            PG8_WAIT_V(6); PG8_BAR; PG8_MMA(1, 1, At, B1); PG8_BAR;
            PG8_LDB(B0, 1, 0); PG8_SCHED; PG8_LDA(At, 1, 0); PG8_STAGE(PG8_SA(0, 1), a2 + hstep, voffA);
            PG8_WAIT_L(8); PG8_BAR; PG8_WAIT_L(0); PG8_MMA(0, 0, At, B0); PG8_BAR; PG8_SCHED;
            PG8_LDB(B1, 1, 1); PG8_STAGE(PG8_SB(1, 0), b3, voffB);
            PG8_BAR; PG8_WAIT_L(0); PG8_MMA(0, 1, At, B1); PG8_BAR;
            PG8_LDA(At, 1, 1); PG8_STAGE(PG8_SA(1, 0), a3, voffA);
            PG8_BAR; PG8_WAIT_L(0); PG8_MMA(1, 0, At, B0); PG8_BAR; PG8_SCHED;
            PG8_STAGE(PG8_SB(1, 1), b3 + hstep, voffB);
            PG8_WAIT_V(6); PG8_BAR; PG8_MMA(1, 1, At, B1); PG8_BAR;
            }
        }
        if constexpr (ALIGN_EPI) { if (wr == 0) PG8_BAR; }
        if constexpr (!Epi::AFTER_DRAIN) { E(acc, cur, wr, wc, fr, fq); S.done(cur); }
        if (!has_next) break;
#pragma unroll
        for (int a = 0; a < 2; ++a)
#pragma unroll
            for (int b = 0; b < 2; ++b)
#pragma unroll
                for (int m = 0; m < 4; ++m)
#pragma unroll
                    for (int n = 0; n < 2; ++n) acc[a][b][m][n] = (f32x4){0.f, 0.f, 0.f, 0.f};
        cur = nxt; cA = nA; cB = nB; ++ui;
        if constexpr (ALIGN_EPI) { if (wr == 1) PG8_BAR; }
    }
    PG8_WAIT_V(0);
    if constexpr (!ALIGN_EPI) { if (wr == 0) PG8_BAR; }
    PG8_BAR;
    if constexpr (Epi::AFTER_DRAIN) { E.fused(acc, cur, wr, wc, fr, fq, lds, wid, lane); S.done(cur); }
#undef PG8_SA
#undef PG8_SB
#undef PG8_STAGE
#undef PG8_LDA
#undef PG8_LDB
#undef PG8_MMA
#undef PG8_WAIT_V
#undef PG8_WAIT_L
#undef PG8_BAR
#undef PG8_SCHED
}
}

#define LAS __attribute__((address_space(3)))
typedef unsigned short bf16;
typedef float f32x4 __attribute__((ext_vector_type(4)));
typedef unsigned u32x4 __attribute__((ext_vector_type(4)));
typedef unsigned u32x2 __attribute__((ext_vector_type(2)));

constexpr int NWAVES = 8, NTHREADS = 512;
constexpr int BATCH = 8, SEQ = 2048, DM = 1024, NH = 16, HD = 64, FF = 4096, M = BATCH * SEQ;
constexpr int NQKV = 3072, NNSA = 2608, NNSA_PAD = 2816;
constexpr float EPS = 1e-6f;
constexpr float QSCALE = 0.125f * 1.4426950408889634f;
constexpr int NSA_KC = 1024, NSA_VC = 1280, NSA_KS = 1536, NSA_VS = 1792, NSA_KW = 2048, NSA_VW = 2304, NSA_G = 2560;
constexpr int NPH = 10, NLAYER = 4;

constexpr size_t MiB = 1u << 20;
constexpr size_t WS_CTL = 0, CTL_BYTES = 1 * MiB;
constexpr size_t WS_ROPE = 1 * MiB;
constexpr size_t WS_KSUM = 1 * MiB + 512 * 1024;
constexpr size_t WS_KCMP = 2 * MiB, WS_VCMP = 2 * MiB + 512 * 1024;
constexpr size_t WS_W = 4 * MiB, W_BUF = 28 * MiB;
constexpr size_t W_IN = 0, W_OUT = 6 * MiB, W_UP = 8 * MiB, W_DOWN = 16 * MiB, W_1K = 24 * MiB, W_1V = 25 * MiB, W_2K = 26 * MiB, W_2V = 26 * MiB + 256 * 1024;
constexpr size_t WS_XN = 60 * MiB;
constexpr size_t WS_QKV = 92 * MiB;
constexpr size_t WS_O = 188 * MiB;
constexpr size_t WS_H = 92 * MiB;
constexpr size_t WS_END = 220 * MiB;

constexpr int LDS_BYTES = 147456;
constexpr int NV_STRIDE = 12288;

#define LDSW() asm volatile("s_waitcnt lgkmcnt(0)" ::: "memory")
__device__ __forceinline__ float bf2f(bf16 v) { return __uint_as_float((unsigned)v << 16); }
__device__ __forceinline__ float bflo(unsigned w) { return __uint_as_float(w << 16); }
__device__ __forceinline__ float bfhi(unsigned w) { return __uint_as_float(w & 0xffff0000u); }
__device__ __forceinline__ unsigned f2bf(float f) { unsigned u = __float_as_uint(f); return (u + 0x7fffu + ((u >> 16) & 1u)) >> 16; }
__device__ __forceinline__ unsigned pk2(float lo, float hi) { return f2bf(lo) | (f2bf(hi) << 16); }
__device__ __forceinline__ float wave_sum(float v) {
#pragma unroll
    for (int o = 1; o < 64; o <<= 1) v += __shfl_xor(v, o);
    return v;
}
__device__ __forceinline__ float wave_max(float v) {
#pragma unroll
    for (int o = 1; o < 64; o <<= 1) v = fmaxf(v, __shfl_xor(v, o));
    return v;
}
__device__ __forceinline__ float ex2(float x) { return __builtin_amdgcn_exp2f(x); }
__device__ __forceinline__ float lg2(float x) { return __builtin_amdgcn_logf(x); }

struct Args { const float* in[39]; float* out; unsigned char* ws; int ph_lo, ph_hi; };

struct LayerPtrs { const float *g_pre, *w_in, *w_out, *g_post, *g_mlp_pre, *w_up, *w_down, *g_mlp_post, *pos_k, *w1_k, *w2_k, *pos_v, *w1_v, *w2_v; };
constexpr int PTAB_OFF = 131072 + 1024;
__device__ __forceinline__ const float* ld_ptr(LAS unsigned char* lds, int i) {
    const LAS unsigned* p = (const LAS unsigned*)(lds + PTAB_OFF) + 2 * i;
    const unsigned lo = __builtin_amdgcn_readfirstlane(p[0]), hi = __builtin_amdgcn_readfirstlane(p[1]);
    return (const float*)(((unsigned long long)hi << 32) | lo);
}
__device__ __forceinline__ LayerPtrs layer_ptrs(LAS unsigned char* lds, int L) {
    LayerPtrs p;
    const int base = (L == 0) ? 1 : (L == 1) ? 9 : (L == 2) ? 17 : 31; const int o = (L == 2) ? 6 : 0;
    p.g_pre = ld_ptr(lds, base); p.w_in = ld_ptr(lds, base + 1);
    p.pos_k = ld_ptr(lds, 19); p.w1_k = ld_ptr(lds, 20); p.w2_k = ld_ptr(lds, 21); p.pos_v = ld_ptr(lds, 22); p.w1_v = ld_ptr(lds, 23); p.w2_v = ld_ptr(lds, 24);
    p.w_out = ld_ptr(lds, base + 2 + o); p.g_post = ld_ptr(lds, base + 3 + o); p.g_mlp_pre = ld_ptr(lds, base + 4 + o); p.w_up = ld_ptr(lds, base + 5 + o); p.w_down = ld_ptr(lds, base + 6 + o); p.g_mlp_post = ld_ptr(lds, base + 7 + o);
    return p;
}

struct Frame {
    LAS unsigned char* lds; int tid, lane, wave, G, gw, ngw;
    unsigned char* ws; float* xres;
};

__device__ __forceinline__ void conv_item(const float* W, int K, int N, bf16* WT, LAS float* scr, int item, int nblk, int lane) {
    const int kb = item / nblk, nb = item % nblk, k0 = 64 * kb, n0 = 32 * nb;
    const int n = n0 + (lane & 31);
#pragma unroll 8
    for (int i = 0; i < 32; ++i) { const int kk = 2 * i + (lane >> 5); scr[kk * 33 + (lane & 31)] = (n < N) ? W[(size_t)(k0 + kk) * N + n] : 0.f; }
    LDSW();
    const int c = lane & 7;
#pragma unroll
    for (int j = 0; j < 4; ++j) { const int nn = (lane >> 3) + 8 * j; const LAS float* s = scr + (8 * c) * 33 + nn;
        u32x4 o; o.x = pk2(s[0 * 33], s[1 * 33]); o.y = pk2(s[2 * 33], s[3 * 33]); o.z = pk2(s[4 * 33], s[5 * 33]); o.w = pk2(s[6 * 33], s[7 * 33]);
        *(u32x4*)(WT + (size_t)(n0 + nn) * K + k0 + 8 * c) = o; }
    LDSW();
}
__device__ __forceinline__ void phase_conv(Frame& F, int L) {
    const LayerPtrs P = layer_ptrs(F.lds, L); const int kind = L % 3;
    LAS float* scr = (LAS float*)(F.lds + F.wave * NV_STRIDE);
    unsigned char* wb = F.ws + WS_W + (size_t)(L & 1) * W_BUF;
    const int npad_in = (kind == 2) ? NNSA_PAD : NQKV, n_in = (kind == 2) ? NNSA : NQKV;
    const int I_IN = (DM / 64) * (npad_in / 32), I_OUT = (DM / 64) * (DM / 32), I_UP = (DM / 64) * (FF / 32), I_DN = (FF / 64) * (DM / 32);
    const int NIT = I_IN + I_OUT + I_UP + I_DN;
    for (int it = F.gw; it < NIT; it += F.ngw) {
        int r = it;
        if (r < I_IN) { conv_item(P.w_in, DM, n_in, (bf16*)(wb + W_IN), scr, r, npad_in / 32, F.lane); continue; } r -= I_IN;
        if (r < I_OUT) { conv_item(P.w_out, DM, DM, (bf16*)(wb + W_OUT), scr, r, DM / 32, F.lane); continue; } r -= I_OUT;
        if (r < I_UP) { conv_item(P.w_up, DM, FF, (bf16*)(wb + W_UP), scr, r, FF / 32, F.lane); continue; } r -= I_UP;
        conv_item(P.w_down, FF, DM, (bf16*)(wb + W_DOWN), scr, r, DM / 32, F.lane);
    }
    if (L == 0) {
        float2* tab = (float2*)(F.ws + WS_ROPE);
        for (int e = F.gw * 64 + F.lane; e < SEQ * 32; e += F.ngw * 64) {
            const int t = e >> 5, i = e & 31;
            double pw = 1.0; for (int k = 0; k < i; ++k) pw *= 1.333521432163324;
            const float pwf = (float)pw; const float inv = 1.0f / pwf; const float ang = (float)t * inv;
            const double x = (double)ang; const double nrev = __builtin_rint(x * 0.15915494309189535); const double r = x - nrev * 6.283185307179586;
            const double r2 = r * r; double cs = 1.0, sn = r, tc = 1.0, tsn = r;
#pragma unroll 1
            for (int k = 1; k <= 14; ++k) { tc *= -r2 / (double)((2 * k - 1) * (2 * k)); tsn *= -r2 / (double)((2 * k) * (2 * k + 1)); cs += tc; sn += tsn; }
            tab[e] = make_float2((float)cs, (float)sn);
        }
        const float* x = ld_ptr(F.lds, 0); bf16* XN = (bf16*)(F.ws + WS_XN);
        f32x4 g[4];
#pragma unroll
        for (int j = 0; j < 4; ++j) g[j] = *((const f32x4*)P.g_pre + F.lane + 64 * j);
        for (int m = F.gw; m < M; m += F.ngw) {
            const f32x4* xr = (const f32x4*)(x + (size_t)m * DM) + F.lane; f32x4 v[4]; float ss = 0.f;
#pragma unroll
            for (int j = 0; j < 4; ++j) { v[j] = xr[64 * j]; ss += (v[j].x * v[j].x + v[j].y * v[j].y) + (v[j].z * v[j].z + v[j].w * v[j].w); }
            const float r = 1.0f / sqrtf(wave_sum(ss) * (1.f / DM) + EPS);
            f32x4* xo = (f32x4*)(F.xres + (size_t)m * DM) + F.lane; u32x2* o8 = (u32x2*)(XN + (size_t)m * DM) + F.lane;
#pragma unroll
            for (int j = 0; j < 4; ++j) { xo[64 * j] = v[j]; u32x2 w; w.x = pk2(v[j].x * r * g[j].x, v[j].y * r * g[j].y); w.y = pk2(v[j].z * r * g[j].z, v[j].w * r * g[j].w); o8[64 * j] = w; }
        }
    }
}

__device__ __forceinline__ void phase_rope(Frame& F, int kind) {
    const float2* tab = (const float2*)(F.ws + WS_ROPE);
    const int np = (kind == 2) ? NNSA_PAD : NQKV; bf16* QKV = (bf16*)(F.ws + WS_QKV);
    for (int m = F.gw; m < M; m += F.ngw) {
        bf16* row = QKV + (size_t)m * np; const int t = m % SEQ;
        if (kind == 1) {
#pragma unroll
            for (int j = 0; j < 16; ++j) { const int c = j * 64 + F.lane; row[c] = (bf16)f2bf(bf2f(row[c]) * QSCALE); }
        } else {
            const int i = F.lane & 31; const float2 cs = tab[t * 32 + i];
            const int nit = (kind == 0) ? 16 : 18;
            for (int it = 0; it < nit; ++it) {
                const int slot = 2 * it + (F.lane >> 5);
                const bool roped = (kind == 0) ? true : (slot < 20 || (slot >= 24 && slot < 28) || (slot >= 32 && slot < 36));
                if (roped) { const float sc = slot < 16 ? QSCALE : 1.0f; bf16* p = row + slot * 64 + i;
                    const float x1 = bf2f(p[0]), x2 = bf2f(p[32]);
                    p[0] = (bf16)f2bf((x1 * cs.x - x2 * cs.y) * sc); p[32] = (bf16)f2bf((x1 * cs.y + x2 * cs.x) * sc); }
            }
        }
    }
}
__device__ __forceinline__ void phase_ksum(Frame& F) {
    const bf16* QKV = (const bf16*)(F.ws + WS_QKV); float* ksum = (float*)(F.ws + WS_KSUM);
    for (int it = F.gw; it < BATCH * 8 * 16; it += F.ngw) {
        const int bn = it >> 4, cc = it & 15; const bf16* p = QKV + (size_t)(bn * 256) * NQKV + 1024 + cc * 64 + F.lane; float s = 0.f;
#pragma unroll 8
        for (int r = 0; r < 256; ++r) s += bf2f(p[(size_t)r * NQKV]);
        ksum[bn * 1024 + cc * 64 + F.lane] = s;
    }
}
__device__ __forceinline__ void phase_norm(Frame& F, const float* ga, const float* gb) {
    bf16* XN = (bf16*)(F.ws + WS_XN);
    f32x4 g1[4], g2[4];
#pragma unroll
    for (int j = 0; j < 4; ++j) { g1[j] = *((const f32x4*)ga + F.lane + 64 * j); g2[j] = gb ? *((const f32x4*)gb + F.lane + 64 * j) : (f32x4){0.f, 0.f, 0.f, 0.f}; }
    for (int m = F.gw; m < M; m += F.ngw) {
        u32x2* y8 = (u32x2*)(XN + (size_t)m * DM) + F.lane; f32x4* xr = (f32x4*)(F.xres + (size_t)m * DM) + F.lane;
        f32x4 y[4], x[4]; float ss = 0.f;
#pragma unroll
        for (int j = 0; j < 4; ++j) { const u32x2 w = y8[64 * j]; y[j] = (f32x4){bflo(w.x), bfhi(w.x), bflo(w.y), bfhi(w.y)}; x[j] = xr[64 * j];
            ss += (y[j].x * y[j].x + y[j].y * y[j].y) + (y[j].z * y[j].z + y[j].w * y[j].w); }
        const float r = 1.0f / sqrtf(wave_sum(ss) * (1.f / DM) + EPS); float s2 = 0.f;
#pragma unroll
        for (int j = 0; j < 4; ++j) { x[j] = x[j] + y[j] * r * g1[j]; xr[64 * j] = x[j]; s2 += (x[j].x * x[j].x + x[j].y * x[j].y) + (x[j].z * x[j].z + x[j].w * x[j].w); }
        if (gb) { const float r2 = 1.0f / sqrtf(wave_sum(s2) * (1.f / DM) + EPS);
#pragma unroll
            for (int j = 0; j < 4; ++j) { u32x2 w; w.x = pk2(x[j].x * r2 * g2[j].x, x[j].y * r2 * g2[j].y); w.y = pk2(x[j].z * r2 * g2[j].z, x[j].w * r2 * g2[j].w); y8[64 * j] = w; } }
    }
}

struct NvScr { LAS float* sc; LAS int* kp; LAS float* qs; LAS float* imp; LAS int* seg; LAS float* hid; };
__device__ __forceinline__ NvScr nv_scr(LAS unsigned char* lds, int wave) {
    LAS unsigned char* b = lds + wave * NV_STRIDE; NvScr s;
    s.sc = (LAS float*)b; s.kp = (LAS int*)(b + 4352); s.qs = (LAS float*)(b + 8704); s.imp = (LAS float*)(b + 8960); s.seg = (LAS int*)(b + 9088); s.hid = (LAS float*)(b + 9344); return s;
}
__device__ __forceinline__ float nv_dot(const bf16* kr, LAS float* qs) {
    float s = 0.f;
#pragma unroll
    for (int c = 0; c < 8; ++c) { const u32x4 w = *(const u32x4*)(kr + 8 * c);
        s += qs[8 * c + 0] * bflo(w.x) + qs[8 * c + 1] * bfhi(w.x) + qs[8 * c + 2] * bflo(w.y) + qs[8 * c + 3] * bfhi(w.y)
           + qs[8 * c + 4] * bflo(w.z) + qs[8 * c + 5] * bfhi(w.z) + qs[8 * c + 6] * bflo(w.w) + qs[8 * c + 7] * bfhi(w.w); }
    return s;
}
__device__ __forceinline__ float nv_attend(const bf16* Kb, const bf16* Vb, int pitch, const NvScr& S, int nseg, int lane, int& n_out) {
    int n = 0;
    for (int i = 0; i < nseg; ++i) { const int st = S.seg[2 * i], ln = S.seg[2 * i + 1]; for (int k = lane; k < ln; k += 64) S.kp[n + k] = st + k; n += ln; }
    LDSW();
    float mx = -INFINITY;
    for (int k = lane; k < n; k += 64) { const float s = nv_dot(Kb + (size_t)S.kp[k] * pitch, S.qs); S.sc[k] = s; mx = fmaxf(mx, s); }
    mx = wave_max(mx);
    float l = 0.f;
    for (int k = lane; k < n; k += 64) { const float p = ex2(S.sc[k] - mx); S.sc[k] = p; l += p; }
    l = wave_sum(l);
    const float inv = (n > 0) ? 1.0f / l : 0.f;
    for (int k = lane; k < n; k += 64) S.sc[k] *= inv;
    LDSW();
    float o = 0.f;
#pragma unroll 4
    for (int k = 0; k < n; ++k) o += S.sc[k] * bf2f(Vb[(size_t)S.kp[k] * pitch + lane]);
    n_out = n;
    return o;
}

__device__ __forceinline__ void phase_moba_simple(Frame& F) {
    const NvScr S = nv_scr(F.lds, F.wave); const int lane = F.lane;
    const bf16* QKV = (const bf16*)(F.ws + WS_QKV); bf16* O = (bf16*)(F.ws + WS_O); const float* ksum = (const float*)(F.ws + WS_KSUM);
    for (int item = F.gw; item < BATCH * NH * SEQ; item += F.ngw) {
        const int b = item / (NH * SEQ), h = (item / SEQ) % NH, t = item % SEQ, m = b * SEQ + t, qblk = t >> 8;
        const float qd = bf2f(QKV[(size_t)m * NQKV + h * 64 + lane]);
        S.qs[lane] = qd;
        unsigned selmask;
        if (qblk <= 3) selmask = (1u << qblk) - 1u;
        else {
            float gv = -INFINITY;
            for (int n = 0; n < qblk; ++n) { const float g = wave_sum(qd * ksum[(b * 8 + n) * 1024 + h * 64 + lane]); if (lane == n) gv = g; }
            int rank = 0;
            for (int n = 0; n < qblk; ++n) { const float gp = __shfl(gv, n); rank += ((gp > gv) || (gp == gv && n < lane)) ? 1 : 0; }
            selmask = (unsigned)__ballot(lane < qblk && rank < 3);
        }
        if (lane == 0) { int ns = 0; S.seg[0] = b * SEQ + 256 * qblk; S.seg[1] = t - 256 * qblk + 1; ns = 1;
            for (int n = 0; n < 8; ++n) if ((selmask >> n) & 1u) { S.seg[2 * ns] = b * SEQ + 256 * n; S.seg[2 * ns + 1] = 256; ++ns; } }
        LDSW();
        const int nseg = 1 + __popc(selmask); int nk;
        const float o = nv_attend(QKV + 1024 + h * 64, QKV + 2048 + h * 64, NQKV, S, nseg, lane, nk);
        O[(size_t)m * DM + h * 64 + lane] = (bf16)f2bf(o);
        LDSW();
    }
}

__device__ __forceinline__ void phase_sb_simple(Frame& F) {
    const NvScr S = nv_scr(F.lds, F.wave); const int lane = F.lane;
    const bf16* QKV = (const bf16*)(F.ws + WS_QKV); bf16* O = (bf16*)(F.ws + WS_O);
    for (int item = F.gw; item < BATCH * NH * SEQ; item += F.ngw) {
        const int b = item / (NH * SEQ), h = (item / SEQ) % NH, t = item % SEQ, m = b * SEQ + t;
        S.qs[lane] = bf2f(QKV[(size_t)m * NQKV + h * 64 + lane]);
        LDSW();
        const bf16* Kb = QKV + (size_t)(b * SEQ) * NQKV + 1024 + h * 64; const bf16* Vb = QKV + (size_t)(b * SEQ) * NQKV + 2048 + h * 64 + lane;
        float o = 0.f, carry = 0.f;
        for (int base = t - 1; base >= 0; base -= 64) {
            const int pos = base - lane; const bool valid = pos >= 0;
            const float z = valid ? nv_dot(Kb + (size_t)pos * NQKV, S.qs) : 0.f;
            const float lb = fminf(z, 0.f) - lg2(1.0f + ex2(-fabsf(z)));
            const float l1 = valid ? lb - z : 0.f;
            float incl = l1;
#pragma unroll
            for (int o2 = 1; o2 < 64; o2 <<= 1) { const float v = __shfl_up(incl, o2); if (lane >= o2) incl += v; }
            const float total = __shfl(incl, 63);
            const float w = valid ? ex2(lb + carry + (incl - l1)) : 0.f;
            S.sc[lane] = w; LDSW();
            const int nk = base + 1 < 64 ? base + 1 : 64;
#pragma unroll 4
            for (int i = 0; i < nk; ++i) o += S.sc[i] * bf2f(Vb[(size_t)(base - i) * NQKV]);
            carry += total; LDSW();
            if (carry < -150.f) break;
        }
        O[(size_t)m * DM + h * 64 + lane] = (bf16)f2bf(o);
    }
}

__device__ __forceinline__ float gelu_tanh(float x) { const float u = 0.7978845608028654f * (x + 0.044715f * x * x * x); return 0.5f * x * (1.0f + tanhf(u)); }
__device__ __forceinline__ void phase_compress_simple(Frame& F, const LayerPtrs& P) {
    const NvScr S = nv_scr(F.lds, F.wave); const int lane = F.lane;
    const bf16* QKV = (const bf16*)(F.ws + WS_QKV);
    for (int item = F.gw; item < 2 * 32 * 128; item += F.ngw) {
        const int kv = item / (32 * 128), bg = (item / 128) % 32, c = item % 128, b = bg >> 2, g = bg & 3;
        bf16* out = (bf16*)(F.ws + (kv ? WS_VCMP : WS_KCMP)) + (size_t)(bg * 128 + c) * 64;
        if (c == 127) { out[lane] = 0; continue; }
        const float* pos = kv ? P.pos_v : P.pos_k; const float* w1 = kv ? P.w1_v : P.w1_k; const float* w2 = kv ? P.w2_v : P.w2_k;
        const int colbase = (kv ? NSA_VC : NSA_KC) + g * 64;
        f32x4 acc = {0.f, 0.f, 0.f, 0.f};
        for (int l = 0; l < 32; ++l) {
            const float av = bf2f(QKV[(size_t)(b * SEQ + 16 * c + l) * NNSA_PAD + colbase + lane]) + pos[l * 64 + lane];
#pragma unroll 8
            for (int d = 0; d < 64; ++d) { const float a = __shfl(av, d); const f32x4 w = *((const f32x4*)(w1 + (size_t)(l * 64 + d) * 256) + lane); acc += a * w; }
        }
        S.hid[4 * lane + 0] = gelu_tanh(acc.x); S.hid[4 * lane + 1] = gelu_tanh(acc.y); S.hid[4 * lane + 2] = gelu_tanh(acc.z); S.hid[4 * lane + 3] = gelu_tanh(acc.w);
        LDSW();
        float o = 0.f;
#pragma unroll 8
        for (int n = 0; n < 256; ++n) o += S.hid[n] * w2[n * 64 + lane];
        out[lane] = (bf16)f2bf(o);
        LDSW();
    }
}

__device__ __forceinline__ void phase_nsa_simple(Frame& F) {
    const NvScr S = nv_scr(F.lds, F.wave); const int lane = F.lane;
    const bf16* QKV = (const bf16*)(F.ws + WS_QKV); bf16* O = (bf16*)(F.ws + WS_O);
    for (int item = F.gw; item < BATCH * 4 * SEQ; item += F.ngw) {
        const int b = item / (4 * SEQ), g = (item / SEQ) & 3, t = item % SEQ, m = b * SEQ + t, qb = t >> 6;
        const bf16* row = QKV + (size_t)m * NNSA_PAD;
        const bf16* Kc = (const bf16*)(F.ws + WS_KCMP) + (size_t)(b * 4 + g) * 128 * 64; const bf16* Vc = (const bf16*)(F.ws + WS_VCMP) + (size_t)(b * 4 + g) * 128 * 64;
        if (lane < 32) S.imp[lane] = 0.f;
        const int ncmp = t >= 31 ? ((t - 31) >> 4) + 1 : 0;
        float ocmp[4];
#pragma unroll
        for (int hh = 0; hh < 4; ++hh) {
            S.qs[lane] = bf2f(row[(4 * g + hh) * 64 + lane]);
            if (lane == 0) { S.seg[0] = 0; S.seg[1] = ncmp; }
            LDSW();
            int nk; ocmp[hh] = nv_attend(Kc, Vc, 64, S, ncmp > 0 ? 1 : 0, lane, nk);
            if (lane < 32) { const int c0 = 4 * lane; float a = 0.f;
                if (c0 - 1 >= 0 && c0 - 1 < ncmp) a += 0.5f * S.sc[c0 - 1];
                if (c0 < ncmp) a += S.sc[c0]; if (c0 + 1 < ncmp) a += S.sc[c0 + 1]; if (c0 + 2 < ncmp) a += S.sc[c0 + 2];
                if (c0 + 3 < ncmp) a += 0.5f * S.sc[c0 + 3];
                S.imp[lane] += a; }
            LDSW();
        }
        unsigned selmask;
        if (qb < 16) selmask = (1u << (qb + 1)) - 1u;
        else {
            const int j = lane & 31; const float vj = S.imp[j]; int rank = 0;
            for (int jp = 1; jp <= qb - 2; ++jp) { const float vp = S.imp[jp]; rank += ((vp > vj) || (vp == vj && jp < j)) ? 1 : 0; }
            const bool forced = (j == 0) || (j == qb) || (j == qb - 1); const bool cand = (j >= 1) && (j <= qb - 2);
            selmask = (unsigned)__ballot(lane < 32 && (forced || (cand && rank < 13)));
        }
#pragma unroll
        for (int hh = 0; hh < 4; ++hh) {
            const int head = 4 * g + hh;
            S.qs[lane] = bf2f(row[head * 64 + lane]);
            if (lane == 0) { int ns = 0; for (int j = 0; j <= qb; ++j) if ((selmask >> j) & 1u) { S.seg[2 * ns] = b * SEQ + 64 * j; S.seg[2 * ns + 1] = (j < qb) ? 64 : (t - 64 * qb + 1); ++ns; } }
            LDSW();
            int nk; const float oslc = nv_attend(QKV + NSA_KS + g * 64, QKV + NSA_VS + g * 64, NNSA_PAD, S, __popc(selmask), lane, nk);
            LDSW();
            const int w0 = t - 511 > 0 ? t - 511 : 0;
            if (lane == 0) { S.seg[0] = b * SEQ + w0; S.seg[1] = t - w0 + 1; }
            LDSW();
            const float owin = nv_attend(QKV + NSA_KW + g * 64, QKV + NSA_VW + g * 64, NNSA_PAD, S, 1, lane, nk);
            const float g0 = 1.0f / (1.0f + __expf(-bf2f(row[NSA_G + head * 3 + 0]))), g1 = 1.0f / (1.0f + __expf(-bf2f(row[NSA_G + head * 3 + 1]))), g2 = 1.0f / (1.0f + __expf(-bf2f(row[NSA_G + head * 3 + 2])));
            O[(size_t)m * DM + head * 64 + lane] = (bf16)f2bf(g0 * ocmp[hh] + g1 * oslc + g2 * owin);
            LDSW();
        }
    }
}

__device__ __forceinline__ bool phase_active(int ph) { const int L = ph / NPH, p = ph % NPH, kind = L % 3; return !(p == 3 && kind == 1); }

__global__ void __launch_bounds__(NTHREADS, 2) mk_fwd(Args a) {
    extern __shared__ __attribute__((aligned(16))) unsigned char lds[];
    Frame F;
    F.lds = (LAS unsigned char*)lds; F.tid = threadIdx.x; F.lane = F.tid & 63; F.wave = __builtin_amdgcn_readfirstlane(F.tid >> 6);
    F.G = gridDim.x; F.gw = blockIdx.x * NWAVES + F.wave; F.ngw = F.G * NWAVES; F.ws = a.ws; F.xres = a.out;
    if (F.tid < 39) ((LAS unsigned long long*)(F.lds + PTAB_OFF))[F.tid] = (unsigned long long)a.in[F.tid];
    __syncthreads();
    for (int ph = a.ph_lo; ph < a.ph_hi; ++ph) {
        if (!phase_active(ph)) continue;
        { int t_ = threadIdx.x; asm volatile("" : "+v"(t_)); F.tid = t_; F.lane = t_ & 63; F.wave = __builtin_amdgcn_readfirstlane(t_ >> 6); F.gw = blockIdx.x * NWAVES + F.wave; }
        const int L = ph / NPH, p = ph % NPH, kind = L % 3;
        unsigned char* wb = F.ws + WS_W + (size_t)(L & 1) * W_BUF;
        if (p == 0) phase_conv(F, L);
        else if (p == 1) { const int np = (kind == 2) ? NNSA_PAD : NQKV;
            pg8::Gemm g{(const bf16*)(F.ws + WS_XN), (const bf16*)(wb + W_IN), M, np, DM}; pg8::EpiBf16 E{(bf16*)(F.ws + WS_QKV), np, 0};
            pg8::StaticOrder S; S.init(M, np, F.G, (int)blockIdx.x);
            pg8::gemm_phase<pg8::EpiBf16, pg8::StaticOrder, true, true>(F.lds, g, S, E, F.tid); }
        else if (p == 5) {
            pg8::Gemm g{(const bf16*)(F.ws + WS_O), (const bf16*)(wb + W_OUT), M, DM, DM}; pg8::EpiBf16 E{(bf16*)(F.ws + WS_XN), DM, 0};
            pg8::StaticOrder S; S.init(M, DM, F.G, (int)blockIdx.x);
            pg8::gemm_phase<pg8::EpiBf16, pg8::StaticOrder, true, true>(F.lds, g, S, E, F.tid); }
        else if (p == 7) {
            pg8::Gemm g{(const bf16*)(F.ws + WS_XN), (const bf16*)(wb + W_UP), M, FF, DM}; pg8::EpiBf16 E{(bf16*)(F.ws + WS_H), FF, 1};
            pg8::StaticOrder S; S.init(M, FF, F.G, (int)blockIdx.x);
            pg8::gemm_phase<pg8::EpiBf16, pg8::StaticOrder, true, true>(F.lds, g, S, E, F.tid); }
        else if (p == 8) {
            pg8::Gemm g{(const bf16*)(F.ws + WS_H), (const bf16*)(wb + W_DOWN), M, DM, FF}; pg8::EpiBf16 E{(bf16*)(F.ws + WS_XN), DM, 0};
            pg8::StaticOrder S; S.init(M, DM, F.G, (int)blockIdx.x);
            pg8::gemm_phase<pg8::EpiBf16, pg8::StaticOrder, true, true>(F.lds, g, S, E, F.tid); }
        else if (p == 2) phase_rope(F, kind);
        else if (p == 3) { if (kind == 0) phase_ksum(F); else { const LayerPtrs P = layer_ptrs(F.lds, L); phase_compress_simple(F, P); } }
        else if (p == 4) { if (kind == 0) phase_moba_simple(F); else if (kind == 1) phase_sb_simple(F); else phase_nsa_simple(F); }
        else { const LayerPtrs P = layer_ptrs(F.lds, L); const float* gnext = (L + 1 < NLAYER) ? layer_ptrs(F.lds, L + 1).g_pre : nullptr;
            if (p == 6) phase_norm(F, P.g_post, P.g_mlp_pre); else phase_norm(F, P.g_mlp_post, gnext); }
    }
}

extern "C" void kernel_launch(void* const* d_in, const int* in_sizes, int n_in, void* d_out, int out_size, void* d_ws, size_t ws_size, hipStream_t stream) {
    static int grid = 0;
    if (grid == 0) {
        if (n_in != 39 || in_sizes[0] != M * DM || out_size != M * DM || ws_size < WS_END) { fprintf(stderr, "kernel_launch: unexpected problem shape (n_in %d, ws %zu)\n", n_in, ws_size); grid = -1; return; }
        int dev = 0, cus = 0;
        if (hipGetDevice(&dev) != hipSuccess || hipDeviceGetAttribute(&cus, hipDeviceAttributeMultiprocessorCount, dev) != hipSuccess) { grid = -1; return; }
        if (hipFuncSetAttribute((const void*)mk_fwd, hipFuncAttributeMaxDynamicSharedMemorySize, LDS_BYTES) != hipSuccess) { fprintf(stderr, "kernel_launch: hipFuncSetAttribute failed\n"); grid = -1; return; }
        grid = cus;
    }
    if (grid < 0) return;
    Args a{};
    for (int i = 0; i < 39; ++i) a.in[i] = (const float*)d_in[i];
    a.out = (float*)d_out; a.ws = (unsigned char*)d_ws;
    for (int ph = 0; ph < NLAYER * NPH; ++ph) {
        const int L = ph / NPH, p = ph % NPH, kind = L % 3;
        if (p == 3 && kind == 1) continue;
        a.ph_lo = ph; a.ph_hi = ph + 1;
        hipLaunchKernelGGL(mk_fwd, dim3(grid), dim3(NTHREADS), LDS_BYTES, stream, a);
    }
}
```

```cpp
#include <hip/hip_runtime.h>
#include <hip/hip_cooperative_groups.h>
#include <cstdio>
#include <cstdint>
#include <cmath>
namespace pg8 {
#define PG8_LAS __attribute__((address_space(3)))
typedef unsigned short bf16_t;
typedef short bf16x8 __attribute__((ext_vector_type(8)));
typedef float f32x4 __attribute__((ext_vector_type(4)));
typedef unsigned u32x4 __attribute__((ext_vector_type(4)));
constexpr int BM = 256, BK = 64, HALF = 128, HTB = HALF * BK * 2  , STAGE_BYTES = 8 * HTB, NXCD = 8, WGM = 8;

__host__ __device__ __forceinline__ int lds_byte(int r, int c) { const int st = (r >> 4) * 2 + (c >> 5), rr = r & 15, cc = c & 31, ob = rr * 64 + cc * 2; return st * 1024 + (ob ^ (((ob >> 9) & 1) << 5)); }
__host__ __device__ __forceinline__ void stage_rc(int b, int& R, int& C) { const int st = b / 1024, sb = b % 1024, swz = sb ^ (((sb >> 9) & 1) << 5); R = (st >> 1) * 16 + swz / 64; C = (st & 1) * 32 + (swz % 64) / 2; }
__host__ __device__ __forceinline__ int perm32(int rho) { const int n = rho >> 4, i = rho & 15; return 8 * (i >> 2) + 4 * n + (i & 3); }

struct Unit { int pm, pn; };
struct Gemm { const bf16_t* A; const bf16_t* Bt; int M, N, K; };

struct StaticOrder {
    int nM, nN, nwg, G, c;
    __host__ __device__ void init(int M, int N, int G_, int c_) { nM = M / BM; nN = N / BM; nwg = nM * nN; G = G_; c = c_; }
    __host__ __device__ bool next(int i, Unit& u) const {
        const long L = (long)i * G + c; if (L >= nwg) return false;
        int wgid = (int)L; { const int q = nwg / NXCD, r = nwg % NXCD, xcd = wgid % NXCD, off = wgid / NXCD; wgid = (xcd < r ? xcd * (q + 1) : r * (q + 1) + (xcd - r) * q) + off; }
        const int nig = WGM * nN, gid = wgid / nig, fm = gid * WGM, gsz = (nM - fm) < WGM ? (nM - fm) : WGM;
        u.pm = fm + ((wgid % nig) % gsz); u.pn = (wgid % nig) / gsz; return true;
    }
    __device__ __forceinline__ void a_ready(const Unit&) const {}
    __device__ __forceinline__ void done(const Unit&) const {}
};


__device__ __forceinline__ unsigned cvt_pk_bf16(float lo, float hi) { unsigned r; asm volatile("v_cvt_pk_bf16_f32 %0, %1, %2" : "=v"(r) : "v"(lo), "v"(hi)); return r; }

struct EpiBf16 {
    static constexpr bool PERM = true, AFTER_DRAIN = false;
    bf16_t* O; int ldc; int act;
    __device__ __forceinline__ void operator()(const f32x4 (&acc)[2][2][4][2], const Unit& u, int wr, int wc, int fr, int fq) const {
        const int row0 = u.pm * BM + wr * 64 + fr; const int col0 = u.pn * BM + wc * 32 + 8 * fq;
#pragma unroll
        for (int ai = 0; ai < 2; ++ai)
#pragma unroll
            for (int m = 0; m < 4; ++m) { bf16_t* rowp = O + (size_t)(row0 + ai * HALF + m * 16) * ldc + col0;
#pragma unroll
                for (int bj = 0; bj < 2; ++bj) { f32x4 v0 = acc[ai][bj][m][0], v1 = acc[ai][bj][m][1];
                    if (act == 1) {
#pragma unroll
                        for (int e = 0; e < 4; ++e) { const float a = v0[e] > 0.f ? v0[e] : 0.f, b = v1[e] > 0.f ? v1[e] : 0.f; v0[e] = a * a; v1[e] = b * b; } }
                    u32x4 w; w.x = cvt_pk_bf16(v0[0], v0[1]); w.y = cvt_pk_bf16(v0[2], v0[3]); w.z = cvt_pk_bf16(v1[0], v1[1]); w.w = cvt_pk_bf16(v1[2], v1[3]);
                    *(u32x4*)(rowp + bj * HALF) = w; } }
    }
};
template <class Epi, class Sched, bool ALIGN_EPI = false, bool SP2 = false>
__device__ __forceinline__ void gemm_phase(PG8_LAS unsigned char* lds, const Gemm g, const Sched& S, const Epi& E, const int pg8_tid) {
    const int tid = pg8_tid, wid = __builtin_amdgcn_readfirstlane(tid >> 6), lane = tid & 63, wr = wid >> 2, wc = wid & 3, fr = lane & 15, fq = lane >> 4;
    const int K = g.K, nt = K / BK;
    unsigned voffA[2], voffB[2];
#pragma unroll
    for (int i = 0; i < 2; ++i) { int R, C; stage_rc(tid * 16 + i * 8192, R, C); const int Rb = Epi::PERM ? ((R & ~31) + perm32(R & 31)) : R;
        voffA[i] = (unsigned)(R * K + C) * 2u; voffB[i] = (unsigned)(Rb * K + C) * 2u; }
    const size_t kstep = (size_t)(BK * 2);
    const size_t hstep = (size_t)HALF * K * 2;
    const size_t tstep = 2 * hstep;
    const unsigned ldsw = (unsigned)wid * 1024u;
    const int aoff = lds_byte(wr * 64 + fr, fq * 8), boff = lds_byte(wc * 32 + fr, fq * 8);
#define PG8_SA(b, h) (((b) * 2 + (h)) * HTB)
#define PG8_SB(b, h) ((4 + (b) * 2 + (h)) * HTB)
#define PG8_STAGE(bufoff, gbase, voff) do { _Pragma("unroll") for (int _i = 0; _i < 2; ++_i) \
        __builtin_amdgcn_global_load_lds((const unsigned*)((const char*)(gbase) + (voff)[_i]), (PG8_LAS unsigned*)(lds + (bufoff) + ldsw + _i * 8192), 16, 0, 0); } while (0)
#define PG8_LDA(dst, b, h) do { _Pragma("unroll") for (int m = 0; m < 4; ++m) _Pragma("unroll") for (int k = 0; k < 2; ++k) dst[m][k] = *(const PG8_LAS bf16x8*)(lds + PG8_SA(b, h) + aoff + m * 2048 + k * 1024); } while (0)
#define PG8_LDB(dst, b, h) do { _Pragma("unroll") for (int n = 0; n < 2; ++n) _Pragma("unroll") for (int k = 0; k < 2; ++k) dst[n][k] = *(const PG8_LAS bf16x8*)(lds + PG8_SB(b, h) + boff + n * 2048 + k * 1024); } while (0)
#define PG8_MMA(ai, bj, At, Bt) do { __builtin_amdgcn_s_setprio(1); _Pragma("unroll") for (int m = 0; m < 4; ++m) _Pragma("unroll") for (int n = 0; n < 2; ++n) _Pragma("unroll") for (int k = 0; k < 2; ++k) \
        acc[ai][bj][m][n] = __builtin_amdgcn_mfma_f32_16x16x32_bf16(Bt[n][k], At[m][k], acc[ai][bj][m][n], 0, 0, 0); __builtin_amdgcn_s_setprio(0); } while (0)
#define PG8_WAIT_V(n) asm volatile("s_waitcnt vmcnt(" #n ")" ::: "memory")
#define PG8_WAIT_L(n) asm volatile("s_waitcnt lgkmcnt(" #n ")" ::: "memory")
#define PG8_BAR __builtin_amdgcn_s_barrier()
#define PG8_SCHED __builtin_amdgcn_sched_barrier(0)
    Unit cur, nxt; int ui = 0;
    if (!S.next(0, cur)) return;
    f32x4 acc[2][2][4][2];
#pragma unroll
    for (int a = 0; a < 2; ++a)
#pragma unroll
        for (int b = 0; b < 2; ++b)
#pragma unroll
            for (int m = 0; m < 4; ++m)
#pragma unroll
                for (int n = 0; n < 2; ++n) acc[a][b][m][n] = (f32x4){0.f, 0.f, 0.f, 0.f};
    bf16x8 At[4][2], B0[2][2], B1[2][2];
    const char* cA = (const char*)g.A + (size_t)cur.pm * tstep; const char* cB = (const char*)g.Bt + (size_t)cur.pn * tstep;
    S.a_ready(cur);
    if constexpr (SP2) {
        PG8_STAGE(PG8_SB(0, 0), cB, voffB); PG8_STAGE(PG8_SB(0, 1), cB + hstep, voffB); PG8_STAGE(PG8_SA(0, 0), cA, voffA); PG8_STAGE(PG8_SA(0, 1), cA + hstep, voffA);
        if (wr == 1) PG8_BAR;
        PG8_WAIT_V(2); PG8_BAR;
        PG8_STAGE(PG8_SB(1, 0), cB + kstep, voffB); PG8_STAGE(PG8_SA(1, 0), cA + kstep, voffA); PG8_STAGE(PG8_SB(1, 1), cB + hstep + kstep, voffB);
        PG8_WAIT_V(6); PG8_BAR;
    } else {
        PG8_STAGE(PG8_SB(0, 0), cB, voffB); PG8_STAGE(PG8_SA(0, 0), cA, voffA); PG8_STAGE(PG8_SB(0, 1), cB + hstep, voffB); PG8_STAGE(PG8_SA(0, 1), cA + hstep, voffA);
        if (wr == 1) PG8_BAR;
        PG8_WAIT_V(4); PG8_BAR;
        PG8_STAGE(PG8_SB(1, 0), cB + kstep, voffB); PG8_STAGE(PG8_SA(1, 0), cA + kstep, voffA); PG8_STAGE(PG8_SB(1, 1), cB + hstep + kstep, voffB);
        PG8_WAIT_V(6); PG8_BAR;
    }
    for (;;) {
        const bool has_next = S.next(ui + 1, nxt);
        const char* nA = has_next ? (const char*)g.A + (size_t)nxt.pm * tstep : cA; const char* nB = has_next ? (const char*)g.Bt + (size_t)nxt.pn * tstep : cB;
        for (int t = 0; t < nt; t += 2) {
            const bool last = (t == nt - 2);
            const char* a1 = cA + (size_t)(t + 1) * kstep;
            const char* a2 = last ? nA : cA + (size_t)(t + 2) * kstep; const char* b2 = last ? nB : cB + (size_t)(t + 2) * kstep;
            const char* a3 = a2 + kstep; const char* b3 = b2 + kstep;
            if (last && has_next) S.a_ready(nxt);
            if constexpr (SP2) {
            PG8_LDB(B0, 0, 0); PG8_LDB(B1, 0, 1); PG8_SCHED; PG8_LDA(At, 0, 0); PG8_STAGE(PG8_SA(1, 1), a1 + hstep, voffA);
            PG8_WAIT_V(8); PG8_WAIT_L(0); PG8_BAR; PG8_MMA(0, 0, At, B0); PG8_MMA(0, 1, At, B1); PG8_BAR; PG8_SCHED;
            PG8_LDA(At, 0, 1); PG8_STAGE(PG8_SB(0, 0), b2, voffB); PG8_STAGE(PG8_SB(0, 1), b2 + hstep, voffB); PG8_STAGE(PG8_SA(0, 0), a2, voffA);
            PG8_WAIT_V(8); PG8_WAIT_L(0); PG8_BAR; PG8_MMA(1, 0, At, B0); PG8_MMA(1, 1, At, B1); PG8_BAR; PG8_SCHED;
            PG8_LDB(B0, 1, 0); PG8_LDB(B1, 1, 1); PG8_SCHED; PG8_LDA(At, 1, 0); PG8_STAGE(PG8_SA(0, 1), a2 + hstep, voffA);
            PG8_WAIT_V(8); PG8_WAIT_L(0); PG8_BAR; PG8_MMA(0, 0, At, B0); PG8_MMA(0, 1, At, B1); PG8_BAR; PG8_SCHED;
            PG8_LDA(At, 1, 1); PG8_STAGE(PG8_SB(1, 0), b3, voffB); PG8_STAGE(PG8_SB(1, 1), b3 + hstep, voffB); PG8_STAGE(PG8_SA(1, 0), a3, voffA);
            PG8_WAIT_V(8); PG8_WAIT_L(0); PG8_BAR; PG8_MMA(1, 0, At, B0); PG8_MMA(1, 1, At, B1); PG8_BAR; PG8_SCHED;
            } else {
            PG8_LDB(B0, 0, 0); PG8_SCHED; PG8_LDA(At, 0, 0); PG8_STAGE(PG8_SA(1, 1), a1 + hstep, voffA);
            PG8_WAIT_L(8); PG8_BAR; PG8_WAIT_L(0); PG8_MMA(0, 0, At, B0); PG8_BAR; PG8_SCHED;
            PG8_LDB(B1, 0, 1); PG8_STAGE(PG8_SB(0, 0), b2, voffB);
            PG8_BAR; PG8_WAIT_L(0); PG8_MMA(0, 1, At, B1); PG8_BAR;
            PG8_LDA(At, 0, 1); PG8_STAGE(PG8_SA(0, 0), a2, voffA);
            PG8_BAR; PG8_WAIT_L(0); PG8_MMA(1, 0, At, B0); PG8_BAR; PG8_SCHED;
            PG8_STAGE(PG8_SB(0, 1), b2 + hstep, voffB);
            PG8_WAIT_V(6); PG8_BAR; PG8_MMA(1, 1, At, B1); PG8_BAR;
            PG8_LDB(B0, 1, 0); PG8_SCHED; PG8_LDA(At, 1, 0); PG8_STAGE(PG8_SA(0, 1), a2 + hstep, voffA);
            PG8_WAIT_L(8); PG8_BAR; PG8_WAIT_L(0); PG8_MMA(0, 0, At, B0); PG8_BAR; PG8_SCHED;
            PG8_LDB(B1, 1, 1); PG8_STAGE(PG8_SB(1, 0), b3, voffB);
            PG8_BAR; PG8_WAIT_L(0); PG8_MMA(0, 1, At, B1); PG8_BAR;
            PG8_LDA(At, 1, 1); PG8_STAGE(PG8_SA(1, 0), a3, voffA);
            PG8_BAR; PG8_WAIT_L(0); PG8_MMA(1, 0, At, B0); PG8_BAR; PG8_SCHED;
            PG8_STAGE(PG8_SB(1, 1), b3 + hstep, voffB);
            PG8_WAIT_V(6); PG8_BAR; PG8_MMA(1, 1, At, B1); PG8_BAR;
            }
        }
        if constexpr (ALIGN_EPI) { if (wr == 0) PG8_BAR; }
        if constexpr (!Epi::AFTER_DRAIN) { E(acc, cur, wr, wc, fr, fq); S.done(cur); }
        if (!has_next) break;
#pragma unroll
        for (int a = 0; a < 2; ++a)
#pragma unroll
            for (int b = 0; b < 2; ++b)
#pragma unroll
                for (int m = 0; m < 4; ++m)
#pragma unroll
                    for (int n = 0; n < 2; ++n) acc[a][b][m][n] = (f32x4){0.f, 0.f, 0.f, 0.f};
        cur = nxt; cA = nA; cB = nB; ++ui;
        if constexpr (ALIGN_EPI) { if (wr == 1) PG8_BAR; }
    }
    PG8_WAIT_V(0);
    if constexpr (!ALIGN_EPI) { if (wr == 0) PG8_BAR; }
    PG8_BAR;
    if constexpr (Epi::AFTER_DRAIN) { E.fused(acc, cur, wr, wc, fr, fq, lds, wid, lane); S.done(cur); }
#undef PG8_SA
#undef PG8_SB
#undef PG8_STAGE
#undef PG8_LDA
#undef PG8_LDB
#undef PG8_MMA
#undef PG8_WAIT_V
#undef PG8_WAIT_L
#undef PG8_BAR
#undef PG8_SCHED
}
}

#define LAS __attribute__((address_space(3)))
typedef unsigned short bf16;
typedef float f32x4 __attribute__((ext_vector_type(4)));
typedef unsigned u32x4 __attribute__((ext_vector_type(4)));
typedef unsigned u32x2 __attribute__((ext_vector_type(2)));

constexpr int NWAVES = 8, NTHREADS = 512;
constexpr int BATCH = 8, SEQ = 2048, DM = 1024, NH = 16, HD = 64, FF = 4096, M = BATCH * SEQ;
constexpr int NQKV = 3072, NNSA = 2608, NNSA_PAD = 2816;
constexpr float EPS = 1e-6f;
constexpr float QSCALE = 0.125f * 1.4426950408889634f;
constexpr int NSA_KC = 1024, NSA_VC = 1280, NSA_KS = 1536, NSA_VS = 1792, NSA_KW = 2048, NSA_VW = 2304, NSA_G = 2560;
constexpr int NPH = 10, NLAYER = 4;

constexpr size_t MiB = 1u << 20;
constexpr size_t WS_CTL = 0, CTL_BYTES = 1 * MiB;
constexpr size_t WS_ROPE = 1 * MiB;
constexpr size_t WS_KSUM = 1 * MiB + 512 * 1024;
constexpr size_t WS_KCMP = 2 * MiB, WS_VCMP = 2 * MiB + 512 * 1024;
constexpr size_t WS_W = 4 * MiB, W_BUF = 28 * MiB;
constexpr size_t W_IN = 0, W_OUT = 6 * MiB, W_UP = 8 * MiB, W_DOWN = 16 * MiB, W_1K = 24 * MiB, W_1V = 25 * MiB, W_2K = 26 * MiB, W_2V = 26 * MiB + 256 * 1024;
constexpr size_t WS_XN = 60 * MiB;
constexpr size_t WS_QKV = 92 * MiB;
constexpr size_t WS_O = 188 * MiB;
constexpr size_t WS_H = 92 * MiB;
constexpr size_t WS_END = 220 * MiB;

constexpr int LDS_BYTES = 147456;
constexpr int NV_STRIDE = 12288;

#define LDSW() asm volatile("s_waitcnt lgkmcnt(0)" ::: "memory")
__device__ __forceinline__ float bf2f(bf16 v) { return __uint_as_float((unsigned)v << 16); }
__device__ __forceinline__ float bflo(unsigned w) { return __uint_as_float(w << 16); }
__device__ __forceinline__ float bfhi(unsigned w) { return __uint_as_float(w & 0xffff0000u); }
__device__ __forceinline__ unsigned f2bf(float f) { unsigned u = __float_as_uint(f); return (u + 0x7fffu + ((u >> 16) & 1u)) >> 16; }
__device__ __forceinline__ unsigned pk2(float lo, float hi) { return f2bf(lo) | (f2bf(hi) << 16); }
__device__ __forceinline__ float wave_sum(float v) {
#pragma unroll
    for (int o = 1; o < 64; o <<= 1) v += __shfl_xor(v, o);
    return v;
}
__device__ __forceinline__ float wave_max(float v) {
#pragma unroll
    for (int o = 1; o < 64; o <<= 1) v = fmaxf(v, __shfl_xor(v, o));
    return v;
}
__device__ __forceinline__ float ex2(float x) { return __builtin_amdgcn_exp2f(x); }
__device__ __forceinline__ float lg2(float x) { return __builtin_amdgcn_logf(x); }

struct Args { const float* in[39]; float* out; unsigned char* ws; int ph_lo, ph_hi; };

struct LayerPtrs { const float *g_pre, *w_in, *w_out, *g_post, *g_mlp_pre, *w_up, *w_down, *g_mlp_post, *pos_k, *w1_k, *w2_k, *pos_v, *w1_v, *w2_v; };
constexpr int PTAB_OFF = 131072 + 1024;
__device__ __forceinline__ const float* ld_ptr(LAS unsigned char* lds, int i) {
    const LAS unsigned* p = (const LAS unsigned*)(lds + PTAB_OFF) + 2 * i;
    const unsigned lo = __builtin_amdgcn_readfirstlane(p[0]), hi = __builtin_amdgcn_readfirstlane(p[1]);
    return (const float*)(((unsigned long long)hi << 32) | lo);
}
__device__ __forceinline__ LayerPtrs layer_ptrs(LAS unsigned char* lds, int L) {
    LayerPtrs p;
    const int base = (L == 0) ? 1 : (L == 1) ? 9 : (L == 2) ? 17 : 31; const int o = (L == 2) ? 6 : 0;
    p.g_pre = ld_ptr(lds, base); p.w_in = ld_ptr(lds, base + 1);
    p.pos_k = ld_ptr(lds, 19); p.w1_k = ld_ptr(lds, 20); p.w2_k = ld_ptr(lds, 21); p.pos_v = ld_ptr(lds, 22); p.w1_v = ld_ptr(lds, 23); p.w2_v = ld_ptr(lds, 24);
    p.w_out = ld_ptr(lds, base + 2 + o); p.g_post = ld_ptr(lds, base + 3 + o); p.g_mlp_pre = ld_ptr(lds, base + 4 + o); p.w_up = ld_ptr(lds, base + 5 + o); p.w_down = ld_ptr(lds, base + 6 + o); p.g_mlp_post = ld_ptr(lds, base + 7 + o);
    return p;
}

struct Frame {
    LAS unsigned char* lds; int tid, lane, wave, G, gw, ngw;
    unsigned char* ws; float* xres;
};

__device__ __forceinline__ void conv_item(const float* W, int K, int N, bf16* WT, LAS float* scr, int item, int nblk, int lane) {
    const int kb = item / nblk, nb = item % nblk, k0 = 64 * kb, n0 = 32 * nb;
    const int n = n0 + (lane & 31);
#pragma unroll 8
    for (int i = 0; i < 32; ++i) { const int kk = 2 * i + (lane >> 5); scr[kk * 33 + (lane & 31)] = (n < N) ? W[(size_t)(k0 + kk) * N + n] : 0.f; }
    LDSW();
    const int c = lane & 7;
#pragma unroll
    for (int j = 0; j < 4; ++j) { const int nn = (lane >> 3) + 8 * j; const LAS float* s = scr + (8 * c) * 33 + nn;
        u32x4 o; o.x = pk2(s[0 * 33], s[1 * 33]); o.y = pk2(s[2 * 33], s[3 * 33]); o.z = pk2(s[4 * 33], s[5 * 33]); o.w = pk2(s[6 * 33], s[7 * 33]);
        *(u32x4*)(WT + (size_t)(n0 + nn) * K + k0 + 8 * c) = o; }
    LDSW();
}
__device__ __forceinline__ void phase_conv(Frame& F, int L) {
    const LayerPtrs P = layer_ptrs(F.lds, L); const int kind = L % 3;
    LAS float* scr = (LAS float*)(F.lds + F.wave * NV_STRIDE);
    unsigned char* wb = F.ws + WS_W + (size_t)(L & 1) * W_BUF;
    const int npad_in = (kind == 2) ? NNSA_PAD : NQKV, n_in = (kind == 2) ? NNSA : NQKV;
    const int I_IN = (DM / 64) * (npad_in / 32), I_OUT = (DM / 64) * (DM / 32), I_UP = (DM / 64) * (FF / 32), I_DN = (FF / 64) * (DM / 32);
    const int NIT = I_IN + I_OUT + I_UP + I_DN;
    for (int it = F.gw; it < NIT; it += F.ngw) {
        int r = it;
        if (r < I_IN) { conv_item(P.w_in, DM, n_in, (bf16*)(wb + W_IN), scr, r, npad_in / 32, F.lane); continue; } r -= I_IN;
        if (r < I_OUT) { conv_item(P.w_out, DM, DM, (bf16*)(wb + W_OUT), scr, r, DM / 32, F.lane); continue; } r -= I_OUT;
        if (r < I_UP) { conv_item(P.w_up, DM, FF, (bf16*)(wb + W_UP), scr, r, FF / 32, F.lane); continue; } r -= I_UP;
        conv_item(P.w_down, FF, DM, (bf16*)(wb + W_DOWN), scr, r, DM / 32, F.lane);
    }
    if (L == 0) {
        float2* tab = (float2*)(F.ws + WS_ROPE);
        for (int e = F.gw * 64 + F.lane; e < SEQ * 32; e += F.ngw * 64) {
            const int t = e >> 5, i = e & 31;
            double pw = 1.0; for (int k = 0; k < i; ++k) pw *= 1.333521432163324;
            const float pwf = (float)pw; const float inv = 1.0f / pwf; const float ang = (float)t * inv;
            const double x = (double)ang; const double nrev = __builtin_rint(x * 0.15915494309189535); const double r = x - nrev * 6.283185307179586;
            const double r2 = r * r; double cs = 1.0, sn = r, tc = 1.0, tsn = r;
#pragma unroll 1
            for (int k = 1; k <= 14; ++k) { tc *= -r2 / (double)((2 * k - 1) * (2 * k)); tsn *= -r2 / (double)((2 * k) * (2 * k + 1)); cs += tc; sn += tsn; }
            tab[e] = make_float2((float)cs, (float)sn);
        }
        const float* x = ld_ptr(F.lds, 0); bf16* XN = (bf16*)(F.ws + WS_XN);
        f32x4 g[4];
#pragma unroll
        for (int j = 0; j < 4; ++j) g[j] = *((const f32x4*)P.g_pre + F.lane + 64 * j);
        for (int m = F.gw; m < M; m += F.ngw) {
            const f32x4* xr = (const f32x4*)(x + (size_t)m * DM) + F.lane; f32x4 v[4]; float ss = 0.f;
#pragma unroll
            for (int j = 0; j < 4; ++j) { v[j] = xr[64 * j]; ss += (v[j].x * v[j].x + v[j].y * v[j].y) + (v[j].z * v[j].z + v[j].w * v[j].w); }
            const float r = 1.0f / sqrtf(wave_sum(ss) * (1.f / DM) + EPS);
            f32x4* xo = (f32x4*)(F.xres + (size_t)m * DM) + F.lane; u32x2* o8 = (u32x2*)(XN + (size_t)m * DM) + F.lane;
#pragma unroll
            for (int j = 0; j < 4; ++j) { xo[64 * j] = v[j]; u32x2 w; w.x = pk2(v[j].x * r * g[j].x, v[j].y * r * g[j].y); w.y = pk2(v[j].z * r * g[j].z, v[j].w * r * g[j].w); o8[64 * j] = w; }
        }
    }
}

__device__ __forceinline__ void phase_rope(Frame& F, int kind) {
    const float2* tab = (const float2*)(F.ws + WS_ROPE);
    const int np = (kind == 2) ? NNSA_PAD : NQKV; bf16* QKV = (bf16*)(F.ws + WS_QKV);
    for (int m = F.gw; m < M; m += F.ngw) {
        bf16* row = QKV + (size_t)m * np; const int t = m % SEQ;
        if (kind == 1) {
#pragma unroll
            for (int j = 0; j < 16; ++j) { const int c = j * 64 + F.lane; row[c] = (bf16)f2bf(bf2f(row[c]) * QSCALE); }
        } else {
            const int i = F.lane & 31; const float2 cs = tab[t * 32 + i];
            const int nit = (kind == 0) ? 16 : 18;
            for (int it = 0; it < nit; ++it) {
                const int slot = 2 * it + (F.lane >> 5);
                const bool roped = (kind == 0) ? true : (slot < 20 || (slot >= 24 && slot < 28) || (slot >= 32 && slot < 36));
                if (roped) { const float sc = slot < 16 ? QSCALE : 1.0f; bf16* p = row + slot * 64 + i;
                    const float x1 = bf2f(p[0]), x2 = bf2f(p[32]);
                    p[0] = (bf16)f2bf((x1 * cs.x - x2 * cs.y) * sc); p[32] = (bf16)f2bf((x1 * cs.y + x2 * cs.x) * sc); }
            }
        }
    }
}
__device__ __forceinline__ void phase_ksum(Frame& F) {
    const bf16* QKV = (const bf16*)(F.ws + WS_QKV); float* ksum = (float*)(F.ws + WS_KSUM);
    for (int it = F.gw; it < BATCH * 8 * 16; it += F.ngw) {
        const int bn = it >> 4, cc = it & 15; const bf16* p = QKV + (size_t)(bn * 256) * NQKV + 1024 + cc * 64 + F.lane; float s = 0.f;
#pragma unroll 8
        for (int r = 0; r < 256; ++r) s += bf2f(p[(size_t)r * NQKV]);
        ksum[bn * 1024 + cc * 64 + F.lane] = s;
    }
}
__device__ __forceinline__ void phase_norm(Frame& F, const float* ga, const float* gb) {
    bf16* XN = (bf16*)(F.ws + WS_XN);
    f32x4 g1[4], g2[4];
#pragma unroll
    for (int j = 0; j < 4; ++j) { g1[j] = *((const f32x4*)ga + F.lane + 64 * j); g2[j] = gb ? *((const f32x4*)gb + F.lane + 64 * j) : (f32x4){0.f, 0.f, 0.f, 0.f}; }
    for (int m = F.gw; m < M; m += F.ngw) {
        u32x2* y8 = (u32x2*)(XN + (size_t)m * DM) + F.lane; f32x4* xr = (f32x4*)(F.xres + (size_t)m * DM) + F.lane;
        f32x4 y[4], x[4]; float ss = 0.f;
#pragma unroll
        for (int j = 0; j < 4; ++j) { const u32x2 w = y8[64 * j]; y[j] = (f32x4){bflo(w.x), bfhi(w.x), bflo(w.y), bfhi(w.y)}; x[j] = xr[64 * j];
            ss += (y[j].x * y[j].x + y[j].y * y[j].y) + (y[j].z * y[j].z + y[j].w * y[j].w); }
        const float r = 1.0f / sqrtf(wave_sum(ss) * (1.f / DM) + EPS); float s2 = 0.f;
#pragma unroll
        for (int j = 0; j < 4; ++j) { x[j] = x[j] + y[j] * r * g1[j]; xr[64 * j] = x[j]; s2 += (x[j].x * x[j].x + x[j].y * x[j].y) + (x[j].z * x[j].z + x[j].w * x[j].w); }
        if (gb) { const float r2 = 1.0f / sqrtf(wave_sum(s2) * (1.f / DM) + EPS);
#pragma unroll
            for (int j = 0; j < 4; ++j) { u32x2 w; w.x = pk2(x[j].x * r2 * g2[j].x, x[j].y * r2 * g2[j].y); w.y = pk2(x[j].z * r2 * g2[j].z, x[j].w * r2 * g2[j].w); y8[64 * j] = w; } }
    }
}

struct NvScr { LAS float* sc; LAS int* kp; LAS float* qs; LAS float* imp; LAS int* seg; LAS float* hid; };
__device__ __forceinline__ NvScr nv_scr(LAS unsigned char* lds, int wave) {
    LAS unsigned char* b = lds + wave * NV_STRIDE; NvScr s;
    s.sc = (LAS float*)b; s.kp = (LAS int*)(b + 4352); s.qs = (LAS float*)(b + 8704); s.imp = (LAS float*)(b + 8960); s.seg = (LAS int*)(b + 9088); s.hid = (LAS float*)(b + 9344); return s;
}
__device__ __forceinline__ float nv_dot(const bf16* kr, LAS float* qs) {
    float s = 0.f;
#pragma unroll
    for (int c = 0; c < 8; ++c) { const u32x4 w = *(const u32x4*)(kr + 8 * c);
        s += qs[8 * c + 0] * bflo(w.x) + qs[8 * c + 1] * bfhi(w.x) + qs[8 * c + 2] * bflo(w.y) + qs[8 * c + 3] * bfhi(w.y)
           + qs[8 * c + 4] * bflo(w.z) + qs[8 * c + 5] * bfhi(w.z) + qs[8 * c + 6] * bflo(w.w) + qs[8 * c + 7] * bfhi(w.w); }
    return s;
}
__device__ __forceinline__ float nv_attend(const bf16* Kb, const bf16* Vb, int pitch, const NvScr& S, int nseg, int lane, int& n_out) {
    int n = 0;
    for (int i = 0; i < nseg; ++i) { const int st = S.seg[2 * i], ln = S.seg[2 * i + 1]; for (int k = lane; k < ln; k += 64) S.kp[n + k] = st + k; n += ln; }
    LDSW();
    float mx = -INFINITY;
    for (int k = lane; k < n; k += 64) { const float s = nv_dot(Kb + (size_t)S.kp[k] * pitch, S.qs); S.sc[k] = s; mx = fmaxf(mx, s); }
    mx = wave_max(mx);
    float l = 0.f;
    for (int k = lane; k < n; k += 64) { const float p = ex2(S.sc[k] - mx); S.sc[k] = p; l += p; }
    l = wave_sum(l);
    const float inv = (n > 0) ? 1.0f / l : 0.f;
    for (int k = lane; k < n; k += 64) S.sc[k] *= inv;
    LDSW();
    float o = 0.f;
#pragma unroll 4
    for (int k = 0; k < n; ++k) o += S.sc[k] * bf2f(Vb[(size_t)S.kp[k] * pitch + lane]);
    n_out = n;
    return o;
}

__device__ __forceinline__ void phase_moba_simple(Frame& F) {
    const NvScr S = nv_scr(F.lds, F.wave); const int lane = F.lane;
    const bf16* QKV = (const bf16*)(F.ws + WS_QKV); bf16* O = (bf16*)(F.ws + WS_O); const float* ksum = (const float*)(F.ws + WS_KSUM);
    for (int item = F.gw; item < BATCH * NH * SEQ; item += F.ngw) {
        const int b = item / (NH * SEQ), h = (item / SEQ) % NH, t = item % SEQ, m = b * SEQ + t, qblk = t >> 8;
        const float qd = bf2f(QKV[(size_t)m * NQKV + h * 64 + lane]);
        S.qs[lane] = qd;
        unsigned selmask;
        if (qblk <= 3) selmask = (1u << qblk) - 1u;
        else {
            float gv = -INFINITY;
            for (int n = 0; n < qblk; ++n) { const float g = wave_sum(qd * ksum[(b * 8 + n) * 1024 + h * 64 + lane]); if (lane == n) gv = g; }
            int rank = 0;
            for (int n = 0; n < qblk; ++n) { const float gp = __shfl(gv, n); rank += ((gp > gv) || (gp == gv && n < lane)) ? 1 : 0; }
            selmask = (unsigned)__ballot(lane < qblk && rank < 3);
        }
        if (lane == 0) { int ns = 0; S.seg[0] = b * SEQ + 256 * qblk; S.seg[1] = t - 256 * qblk + 1; ns = 1;
            for (int n = 0; n < 8; ++n) if ((selmask >> n) & 1u) { S.seg[2 * ns] = b * SEQ + 256 * n; S.seg[2 * ns + 1] = 256; ++ns; } }
        LDSW();
        const int nseg = 1 + __popc(selmask); int nk;
        const float o = nv_attend(QKV + 1024 + h * 64, QKV + 2048 + h * 64, NQKV, S, nseg, lane, nk);
        O[(size_t)m * DM + h * 64 + lane] = (bf16)f2bf(o);
        LDSW();
    }
}

__device__ __forceinline__ void phase_sb_simple(Frame& F) {
    const NvScr S = nv_scr(F.lds, F.wave); const int lane = F.lane;
    const bf16* QKV = (const bf16*)(F.ws + WS_QKV); bf16* O = (bf16*)(F.ws + WS_O);
    for (int item = F.gw; item < BATCH * NH * SEQ; item += F.ngw) {
        const int b = item / (NH * SEQ), h = (item / SEQ) % NH, t = item % SEQ, m = b * SEQ + t;
        S.qs[lane] = bf2f(QKV[(size_t)m * NQKV + h * 64 + lane]);
        LDSW();
        const bf16* Kb = QKV + (size_t)(b * SEQ) * NQKV + 1024 + h * 64; const bf16* Vb = QKV + (size_t)(b * SEQ) * NQKV + 2048 + h * 64 + lane;
        float o = 0.f, carry = 0.f;
        for (int base = t - 1; base >= 0; base -= 64) {
            const int pos = base - lane; const bool valid = pos >= 0;
            const float z = valid ? nv_dot(Kb + (size_t)pos * NQKV, S.qs) : 0.f;
            const float lb = fminf(z, 0.f) - lg2(1.0f + ex2(-fabsf(z)));
            const float l1 = valid ? lb - z : 0.f;
            float incl = l1;
#pragma unroll
            for (int o2 = 1; o2 < 64; o2 <<= 1) { const float v = __shfl_up(incl, o2); if (lane >= o2) incl += v; }
            const float total = __shfl(incl, 63);
            const float w = valid ? ex2(lb + carry + (incl - l1)) : 0.f;
            S.sc[lane] = w; LDSW();
            const int nk = base + 1 < 64 ? base + 1 : 64;
#pragma unroll 4
            for (int i = 0; i < nk; ++i) o += S.sc[i] * bf2f(Vb[(size_t)(base - i) * NQKV]);
            carry += total; LDSW();
            if (carry < -150.f) break;
        }
        O[(size_t)m * DM + h * 64 + lane] = (bf16)f2bf(o);
    }
}

__device__ __forceinline__ float gelu_tanh(float x) { const float u = 0.7978845608028654f * (x + 0.044715f * x * x * x); return 0.5f * x * (1.0f + tanhf(u)); }
__device__ __forceinline__ void phase_compress_simple(Frame& F, const LayerPtrs& P) {
    const NvScr S = nv_scr(F.lds, F.wave); const int lane = F.lane;
    const bf16* QKV = (const bf16*)(F.ws + WS_QKV);
    for (int item = F.gw; item < 2 * 32 * 128; item += F.ngw) {
        const int kv = item / (32 * 128), bg = (item / 128) % 32, c = item % 128, b = bg >> 2, g = bg & 3;
        bf16* out = (bf16*)(F.ws + (kv ? WS_VCMP : WS_KCMP)) + (size_t)(bg * 128 + c) * 64;
        if (c == 127) { out[lane] = 0; continue; }
        const float* pos = kv ? P.pos_v : P.pos_k; const float* w1 = kv ? P.w1_v : P.w1_k; const float* w2 = kv ? P.w2_v : P.w2_k;
        const int colbase = (kv ? NSA_VC : NSA_KC) + g * 64;
        f32x4 acc = {0.f, 0.f, 0.f, 0.f};
        for (int l = 0; l < 32; ++l) {
            const float av = bf2f(QKV[(size_t)(b * SEQ + 16 * c + l) * NNSA_PAD + colbase + lane]) + pos[l * 64 + lane];
#pragma unroll 8
            for (int d = 0; d < 64; ++d) { const float a = __shfl(av, d); const f32x4 w = *((const f32x4*)(w1 + (size_t)(l * 64 + d) * 256) + lane); acc += a * w; }
        }
        S.hid[4 * lane + 0] = gelu_tanh(acc.x); S.hid[4 * lane + 1] = gelu_tanh(acc.y); S.hid[4 * lane + 2] = gelu_tanh(acc.z); S.hid[4 * lane + 3] = gelu_tanh(acc.w);
        LDSW();
        float o = 0.f;
#pragma unroll 8
        for (int n = 0; n < 256; ++n) o += S.hid[n] * w2[n * 64 + lane];
        out[lane] = (bf16)f2bf(o);
        LDSW();
    }
}

__device__ __forceinline__ void phase_nsa_simple(Frame& F) {
    const NvScr S = nv_scr(F.lds, F.wave); const int lane = F.lane;
    const bf16* QKV = (const bf16*)(F.ws + WS_QKV); bf16* O = (bf16*)(F.ws + WS_O);
    for (int item = F.gw; item < BATCH * 4 * SEQ; item += F.ngw) {
        const int b = item / (4 * SEQ), g = (item / SEQ) & 3, t = item % SEQ, m = b * SEQ + t, qb = t >> 6;
        const bf16* row = QKV + (size_t)m * NNSA_PAD;
        const bf16* Kc = (const bf16*)(F.ws + WS_KCMP) + (size_t)(b * 4 + g) * 128 * 64; const bf16* Vc = (const bf16*)(F.ws + WS_VCMP) + (size_t)(b * 4 + g) * 128 * 64;
        if (lane < 32) S.imp[lane] = 0.f;
        const int ncmp = t >= 31 ? ((t - 31) >> 4) + 1 : 0;
        float ocmp[4];
#pragma unroll
        for (int hh = 0; hh < 4; ++hh) {
            S.qs[lane] = bf2f(row[(4 * g + hh) * 64 + lane]);
            if (lane == 0) { S.seg[0] = 0; S.seg[1] = ncmp; }
            LDSW();
            int nk; ocmp[hh] = nv_attend(Kc, Vc, 64, S, ncmp > 0 ? 1 : 0, lane, nk);
            if (lane < 32) { const int c0 = 4 * lane; float a = 0.f;
                if (c0 - 1 >= 0 && c0 - 1 < ncmp) a += 0.5f * S.sc[c0 - 1];
                if (c0 < ncmp) a += S.sc[c0]; if (c0 + 1 < ncmp) a += S.sc[c0 + 1]; if (c0 + 2 < ncmp) a += S.sc[c0 + 2];
                if (c0 + 3 < ncmp) a += 0.5f * S.sc[c0 + 3];
                S.imp[lane] += a; }
            LDSW();
        }
        unsigned selmask;
        if (qb < 16) selmask = (1u << (qb + 1)) - 1u;
        else {
            const int j = lane & 31; const float vj = S.imp[j]; int rank = 0;
            for (int jp = 1; jp <= qb - 2; ++jp) { const float vp = S.imp[jp]; rank += ((vp > vj) || (vp == vj && jp < j)) ? 1 : 0; }
            const bool forced = (j == 0) || (j == qb) || (j == qb - 1); const bool cand = (j >= 1) && (j <= qb - 2);
            selmask = (unsigned)__ballot(lane < 32 && (forced || (cand && rank < 13)));
        }
#pragma unroll
        for (int hh = 0; hh < 4; ++hh) {
            const int head = 4 * g + hh;
            S.qs[lane] = bf2f(row[head * 64 + lane]);
            if (lane == 0) { int ns = 0; for (int j = 0; j <= qb; ++j) if ((selmask >> j) & 1u) { S.seg[2 * ns] = b * SEQ + 64 * j; S.seg[2 * ns + 1] = (j < qb) ? 64 : (t - 64 * qb + 1); ++ns; } }
            LDSW();
            int nk; const float oslc = nv_attend(QKV + NSA_KS + g * 64, QKV + NSA_VS + g * 64, NNSA_PAD, S, __popc(selmask), lane, nk);
            LDSW();
            const int w0 = t - 511 > 0 ? t - 511 : 0;
            if (lane == 0) { S.seg[0] = b * SEQ + w0; S.seg[1] = t - w0 + 1; }
            LDSW();
            const float owin = nv_attend(QKV + NSA_KW + g * 64, QKV + NSA_VW + g * 64, NNSA_PAD, S, 1, lane, nk);
            const float g0 = 1.0f / (1.0f + __expf(-bf2f(row[NSA_G + head * 3 + 0]))), g1 = 1.0f / (1.0f + __expf(-bf2f(row[NSA_G + head * 3 + 1]))), g2 = 1.0f / (1.0f + __expf(-bf2f(row[NSA_G + head * 3 + 2])));
            O[(size_t)m * DM + head * 64 + lane] = (bf16)f2bf(g0 * ocmp[hh] + g1 * oslc + g2 * owin);
            LDSW();
        }
    }
}

__device__ __forceinline__ bool phase_active(int ph) { const int L = ph / NPH, p = ph % NPH, kind = L % 3; return !(p == 3 && kind == 1); }

__global__ void __launch_bounds__(NTHREADS, 2) mk_fwd(Args a) {
    extern __shared__ __attribute__((aligned(16))) unsigned char lds[];
    Frame F;
    F.lds = (LAS unsigned char*)lds; F.tid = threadIdx.x; F.lane = F.tid & 63; F.wave = __builtin_amdgcn_readfirstlane(F.tid >> 6);
    F.G = gridDim.x; F.gw = blockIdx.x * NWAVES + F.wave; F.ngw = F.G * NWAVES; F.ws = a.ws; F.xres = a.out;
    if (F.tid < 39) ((LAS unsigned long long*)(F.lds + PTAB_OFF))[F.tid] = (unsigned long long)a.in[F.tid];
    __syncthreads();
    for (int ph = a.ph_lo; ph < a.ph_hi; ++ph) {
        if (!phase_active(ph)) continue;
        { int t_ = threadIdx.x; asm volatile("" : "+v"(t_)); F.tid = t_; F.lane = t_ & 63; F.wave = __builtin_amdgcn_readfirstlane(t_ >> 6); F.gw = blockIdx.x * NWAVES + F.wave; }
        const int L = ph / NPH, p = ph % NPH, kind = L % 3;
        unsigned char* wb = F.ws + WS_W + (size_t)(L & 1) * W_BUF;
        if (p == 0) phase_conv(F, L);
        else if (p == 1) { const int np = (kind == 2) ? NNSA_PAD : NQKV;
            pg8::Gemm g{(const bf16*)(F.ws + WS_XN), (const bf16*)(wb + W_IN), M, np, DM}; pg8::EpiBf16 E{(bf16*)(F.ws + WS_QKV), np, 0};
            pg8::StaticOrder S; S.init(M, np, F.G, (int)blockIdx.x);
            pg8::gemm_phase<pg8::EpiBf16, pg8::StaticOrder, true, true>(F.lds, g, S, E, F.tid); }
        else if (p == 5) {
            pg8::Gemm g{(const bf16*)(F.ws + WS_O), (const bf16*)(wb + W_OUT), M, DM, DM}; pg8::EpiBf16 E{(bf16*)(F.ws + WS_XN), DM, 0};
            pg8::StaticOrder S; S.init(M, DM, F.G, (int)blockIdx.x);
            pg8::gemm_phase<pg8::EpiBf16, pg8::StaticOrder, true, true>(F.lds, g, S, E, F.tid); }
        else if (p == 7) {
            pg8::Gemm g{(const bf16*)(F.ws + WS_XN), (const bf16*)(wb + W_UP), M, FF, DM}; pg8::EpiBf16 E{(bf16*)(F.ws + WS_H), FF, 1};
            pg8::StaticOrder S; S.init(M, FF, F.G, (int)blockIdx.x);
            pg8::gemm_phase<pg8::EpiBf16, pg8::StaticOrder, true, true>(F.lds, g, S, E, F.tid); }
        else if (p == 8) {
            pg8::Gemm g{(const bf16*)(F.ws + WS_H), (const bf16*)(wb + W_DOWN), M, DM, FF}; pg8::EpiBf16 E{(bf16*)(F.ws + WS_XN), DM, 0};
            pg8::StaticOrder S; S.init(M, DM, F.G, (int)blockIdx.x);
            pg8::gemm_phase<pg8::EpiBf16, pg8::StaticOrder, true, true>(F.lds, g, S, E, F.tid); }
        else if (p == 2) phase_rope(F, kind);
        else if (p == 3) { if (kind == 0) phase_ksum(F); else { const LayerPtrs P = layer_ptrs(F.lds, L); phase_compress_simple(F, P); } }
        else if (p == 4) { if (kind == 0) phase_moba_simple(F); else if (kind == 1) phase_sb_simple(F); else phase_nsa_simple(F); }
        else { const LayerPtrs P = layer_ptrs(F.lds, L); const float* gnext = (L + 1 < NLAYER) ? layer_ptrs(F.lds, L + 1).g_pre : nullptr;
            if (p == 6) phase_norm(F, P.g_post, P.g_mlp_pre); else phase_norm(F, P.g_mlp_post, gnext); }
        if (ph + 1 < a.ph_hi) cooperative_groups::this_grid().sync();
    }
}

extern "C" void kernel_launch(void* const* d_in, const int* in_sizes, int n_in, void* d_out, int out_size, void* d_ws, size_t ws_size, hipStream_t stream) {
    static int grid = 0;
    if (grid == 0) {
        if (n_in != 39 || in_sizes[0] != M * DM || out_size != M * DM || ws_size < WS_END) { fprintf(stderr, "kernel_launch: unexpected problem shape (n_in %d, ws %zu)\n", n_in, ws_size); grid = -1; return; }
        int dev = 0, cus = 0;
        if (hipGetDevice(&dev) != hipSuccess || hipDeviceGetAttribute(&cus, hipDeviceAttributeMultiprocessorCount, dev) != hipSuccess) { grid = -1; return; }
        if (hipFuncSetAttribute((const void*)mk_fwd, hipFuncAttributeMaxDynamicSharedMemorySize, LDS_BYTES) != hipSuccess) { fprintf(stderr, "kernel_launch: hipFuncSetAttribute failed\n"); grid = -1; return; }
        int per_cu = 0;
        if (hipOccupancyMaxActiveBlocksPerMultiprocessor(&per_cu, (const void*)mk_fwd, NTHREADS, LDS_BYTES) != hipSuccess || per_cu < 1) { fprintf(stderr, "kernel_launch: occupancy query failed (%d)\n", per_cu); grid = -1; return; }
        grid = cus;
    }
    if (grid < 0) return;
    Args a{};
    for (int i = 0; i < 39; ++i) a.in[i] = (const float*)d_in[i];
    a.out = (float*)d_out; a.ws = (unsigned char*)d_ws; a.ph_lo = 0; a.ph_hi = NLAYER * NPH;
    void* kargs[] = {&a};
    const hipError_t e = hipLaunchCooperativeKernel((const void*)mk_fwd, dim3(grid), dim3(NTHREADS), kargs, LDS_BYTES, stream);
    if (e != hipSuccess) fprintf(stderr, "kernel_launch: cooperative launch failed: %s (grid %d)\n", hipGetErrorString(e), grid);
}
```

```cpp
#include <hip/hip_runtime.h>
#include <hip/hip_cooperative_groups.h>
#include <cstdio>
#include <cstdint>
#include <cmath>
namespace pg8 {
#define PG8_LAS __attribute__((address_space(3)))
typedef unsigned short bf16_t;
typedef short bf16x8 __attribute__((ext_vector_type(8)));
typedef float f32x4 __attribute__((ext_vector_type(4)));
typedef unsigned u32x4 __attribute__((ext_vector_type(4)));
constexpr int BM = 256, BK = 64, HALF = 128, HTB = HALF * BK * 2  , STAGE_BYTES = 8 * HTB, NXCD = 8, WGM = 8;

__host__ __device__ __forceinline__ int lds_byte(int r, int c) { const int st = (r >> 4) * 2 + (c >> 5), rr = r & 15, cc = c & 31, ob = rr * 64 + cc * 2; return st * 1024 + (ob ^ (((ob >> 9) & 1) << 5)); }
__host__ __device__ __forceinline__ void stage_rc(int b, int& R, int& C) { const int st = b / 1024, sb = b % 1024, swz = sb ^ (((sb >> 9) & 1) << 5); R = (st >> 1) * 16 + swz / 64; C = (st & 1) * 32 + (swz % 64) / 2; }
__host__ __device__ __forceinline__ int perm32(int rho) { const int n = rho >> 4, i = rho & 15; return 8 * (i >> 2) + 4 * n + (i & 3); }

struct Unit { int pm, pn; };
struct Gemm { const bf16_t* A; const bf16_t* Bt; int M, N, K; };

struct StaticOrder {
    int nM, nN, nwg, G, c;
    __host__ __device__ void init(int M, int N, int G_, int c_) { nM = M / BM; nN = N / BM; nwg = nM * nN; G = G_; c = c_; }
    __host__ __device__ bool next(int i, Unit& u) const {
        const long L = (long)i * G + c; if (L >= nwg) return false;
        int wgid = (int)L; { const int q = nwg / NXCD, r = nwg % NXCD, xcd = wgid % NXCD, off = wgid / NXCD; wgid = (xcd < r ? xcd * (q + 1) : r * (q + 1) + (xcd - r) * q) + off; }
        const int nig = WGM * nN, gid = wgid / nig, fm = gid * WGM, gsz = (nM - fm) < WGM ? (nM - fm) : WGM;
        u.pm = fm + ((wgid % nig) % gsz); u.pn = (wgid % nig) / gsz; return true;
    }
    __device__ __forceinline__ void a_ready(const Unit&) const {}
    __device__ __forceinline__ void done(const Unit&) const {}
};


__device__ __forceinline__ unsigned cvt_pk_bf16(float lo, float hi) { unsigned r; asm volatile("v_cvt_pk_bf16_f32 %0, %1, %2" : "=v"(r) : "v"(lo), "v"(hi)); return r; }

struct EpiBf16 {
    static constexpr bool PERM = true, AFTER_DRAIN = false;
    bf16_t* O; int ldc; int act;
    __device__ __forceinline__ void operator()(const f32x4 (&acc)[2][2][4][2], const Unit& u, int wr, int wc, int fr, int fq) const {
        const int row0 = u.pm * BM + wr * 64 + fr; const int col0 = u.pn * BM + wc * 32 + 8 * fq;
#pragma unroll
        for (int ai = 0; ai < 2; ++ai)
#pragma unroll
            for (int m = 0; m < 4; ++m) { bf16_t* rowp = O + (size_t)(row0 + ai * HALF + m * 16) * ldc + col0;
#pragma unroll
                for (int bj = 0; bj < 2; ++bj) { f32x4 v0 = acc[ai][bj][m][0], v1 = acc[ai][bj][m][1];
                    if (act == 1) {
#pragma unroll
                        for (int e = 0; e < 4; ++e) { const float a = v0[e] > 0.f ? v0[e] : 0.f, b = v1[e] > 0.f ? v1[e] : 0.f; v0[e] = a * a; v1[e] = b * b; } }
                    u32x4 w; w.x = cvt_pk_bf16(v0[0], v0[1]); w.y = cvt_pk_bf16(v0[2], v0[3]); w.z = cvt_pk_bf16(v1[0], v1[1]); w.w = cvt_pk_bf16(v1[2], v1[3]);
                    *(u32x4*)(rowp + bj * HALF) = w; } }
    }
};
template <class Epi, class Sched, bool ALIGN_EPI = false, bool SP2 = false>
__device__ __forceinline__ void gemm_phase(PG8_LAS unsigned char* lds, const Gemm g, const Sched& S, const Epi& E, const int pg8_tid) {
    const int tid = pg8_tid, wid = __builtin_amdgcn_readfirstlane(tid >> 6), lane = tid & 63, wr = wid >> 2, wc = wid & 3, fr = lane & 15, fq = lane >> 4;
    const int K = g.K, nt = K / BK;
    unsigned voffA[2], voffB[2];
#pragma unroll
    for (int i = 0; i < 2; ++i) { int R, C; stage_rc(tid * 16 + i * 8192, R, C); const int Rb = Epi::PERM ? ((R & ~31) + perm32(R & 31)) : R;
        voffA[i] = (unsigned)(R * K + C) * 2u; voffB[i] = (unsigned)(Rb * K + C) * 2u; }
    const size_t kstep = (size_t)(BK * 2);
    const size_t hstep = (size_t)HALF * K * 2;
    const size_t tstep = 2 * hstep;
    const unsigned ldsw = (unsigned)wid * 1024u;
    const int aoff = lds_byte(wr * 64 + fr, fq * 8), boff = lds_byte(wc * 32 + fr, fq * 8);
#define PG8_SA(b, h) (((b) * 2 + (h)) * HTB)
#define PG8_SB(b, h) ((4 + (b) * 2 + (h)) * HTB)
#define PG8_STAGE(bufoff, gbase, voff) do { _Pragma("unroll") for (int _i = 0; _i < 2; ++_i) \
        __builtin_amdgcn_global_load_lds((const unsigned*)((const char*)(gbase) + (voff)[_i]), (PG8_LAS unsigned*)(lds + (bufoff) + ldsw + _i * 8192), 16, 0, 0); } while (0)
#define PG8_LDA(dst, b, h) do { _Pragma("unroll") for (int m = 0; m < 4; ++m) _Pragma("unroll") for (int k = 0; k < 2; ++k) dst[m][k] = *(const PG8_LAS bf16x8*)(lds + PG8_SA(b, h) + aoff + m * 2048 + k * 1024); } while (0)
#define PG8_LDB(dst, b, h) do { _Pragma("unroll") for (int n = 0; n < 2; ++n) _Pragma("unroll") for (int k = 0; k < 2; ++k) dst[n][k] = *(const PG8_LAS bf16x8*)(lds + PG8_SB(b, h) + boff + n * 2048 + k * 1024); } while (0)
#define PG8_MMA(ai, bj, At, Bt) do { __builtin_amdgcn_s_setprio(1); _Pragma("unroll") for (int m = 0; m < 4; ++m) _Pragma("unroll") for (int n = 0; n < 2; ++n) _Pragma("unroll") for (int k = 0; k < 2; ++k) \
        acc[ai][bj][m][n] = __builtin_amdgcn_mfma_f32_16x16x32_bf16(Bt[n][k], At[m][k], acc[ai][bj][m][n], 0, 0, 0); __builtin_amdgcn_s_setprio(0); } while (0)
#define PG8_WAIT_V(n) asm volatile("s_waitcnt vmcnt(" #n ")" ::: "memory")
#define PG8_WAIT_L(n) asm volatile("s_waitcnt lgkmcnt(" #n ")" ::: "memory")
#define PG8_BAR __builtin_amdgcn_s_barrier()
#define PG8_SCHED __builtin_amdgcn_sched_barrier(0)
    Unit cur, nxt; int ui = 0;
    if (!S.next(0, cur)) return;
    f32x4 acc[2][2][4][2];
#pragma unroll
    for (int a = 0; a < 2; ++a)
#pragma unroll
        for (int b = 0; b < 2; ++b)
#pragma unroll
            for (int m = 0; m < 4; ++m)
#pragma unroll
                for (int n = 0; n < 2; ++n) acc[a][b][m][n] = (f32x4){0.f, 0.f, 0.f, 0.f};
    bf16x8 At[4][2], B0[2][2], B1[2][2];
    const char* cA = (const char*)g.A + (size_t)cur.pm * tstep; const char* cB = (const char*)g.Bt + (size_t)cur.pn * tstep;
    S.a_ready(cur);
    if constexpr (SP2) {
        PG8_STAGE(PG8_SB(0, 0), cB, voffB); PG8_STAGE(PG8_SB(0, 1), cB + hstep, voffB); PG8_STAGE(PG8_SA(0, 0), cA, voffA); PG8_STAGE(PG8_SA(0, 1), cA + hstep, voffA);
        if (wr == 1) PG8_BAR;
        PG8_WAIT_V(2); PG8_BAR;
        PG8_STAGE(PG8_SB(1, 0), cB + kstep, voffB); PG8_STAGE(PG8_SA(1, 0), cA + kstep, voffA); PG8_STAGE(PG8_SB(1, 1), cB + hstep + kstep, voffB);
        PG8_WAIT_V(6); PG8_BAR;
    } else {
        PG8_STAGE(PG8_SB(0, 0), cB, voffB); PG8_STAGE(PG8_SA(0, 0), cA, voffA); PG8_STAGE(PG8_SB(0, 1), cB + hstep, voffB); PG8_STAGE(PG8_SA(0, 1), cA + hstep, voffA);
        if (wr == 1) PG8_BAR;
        PG8_WAIT_V(4); PG8_BAR;
        PG8_STAGE(PG8_SB(1, 0), cB + kstep, voffB); PG8_STAGE(PG8_SA(1, 0), cA + kstep, voffA); PG8_STAGE(PG8_SB(1, 1), cB + hstep + kstep, voffB);
        PG8_WAIT_V(6); PG8_BAR;
    }
    for (;;) {
        const bool has_next = S.next(ui + 1, nxt);
        const char* nA = has_next ? (const char*)g.A + (size_t)nxt.pm * tstep : cA; const char* nB = has_next ? (const char*)g.Bt + (size_t)nxt.pn * tstep : cB;
        for (int t = 0; t < nt; t += 2) {
            const bool last = (t == nt - 2);
            const char* a1 = cA + (size_t)(t + 1) * kstep;
            const char* a2 = last ? nA : cA + (size_t)(t + 2) * kstep; const char* b2 = last ? nB : cB + (size_t)(t + 2) * kstep;
            const char* a3 = a2 + kstep; const char* b3 = b2 + kstep;
            if (last && has_next) S.a_ready(nxt);
            if constexpr (SP2) {
            PG8_LDB(B0, 0, 0); PG8_LDB(B1, 0, 1); PG8_SCHED; PG8_LDA(At, 0, 0); PG8_STAGE(PG8_SA(1, 1), a1 + hstep, voffA);
            PG8_WAIT_V(8); PG8_WAIT_L(0); PG8_BAR; PG8_MMA(0, 0, At, B0); PG8_MMA(0, 1, At, B1); PG8_BAR; PG8_SCHED;
            PG8_LDA(At, 0, 1); PG8_STAGE(PG8_SB(0, 0), b2, voffB); PG8_STAGE(PG8_SB(0, 1), b2 + hstep, voffB); PG8_STAGE(PG8_SA(0, 0), a2, voffA);
            PG8_WAIT_V(8); PG8_WAIT_L(0); PG8_BAR; PG8_MMA(1, 0, At, B0); PG8_MMA(1, 1, At, B1); PG8_BAR; PG8_SCHED;
            PG8_LDB(B0, 1, 0); PG8_LDB(B1, 1, 1); PG8_SCHED; PG8_LDA(At, 1, 0); PG8_STAGE(PG8_SA(0, 1), a2 + hstep, voffA);
            PG8_WAIT_V(8); PG8_WAIT_L(0); PG8_BAR; PG8_MMA(0, 0, At, B0); PG8_MMA(0, 1, At, B1); PG8_BAR; PG8_SCHED;
            PG8_LDA(At, 1, 1); PG8_STAGE(PG8_SB(1, 0), b3, voffB); PG8_STAGE(PG8_SB(1, 1), b3 + hstep, voffB); PG8_STAGE(PG8_SA(1, 0), a3, voffA);
            PG8_WAIT_V(8); PG8_WAIT_L(0); PG8_BAR; PG8_MMA(1, 0, At, B0); PG8_MMA(1, 1, At, B1); PG8_BAR; PG8_SCHED;
            } else {
            PG8_LDB(B0, 0, 0); PG8_SCHED; PG8_LDA(At, 0, 0); PG8_STAGE(PG8_SA(1, 1), a1 + hstep, voffA);
            PG8_WAIT_L(8); PG8_BAR; PG8_WAIT_L(0); PG8_MMA(0, 0, At, B0); PG8_BAR; PG8_SCHED;
            PG8_LDB(B1, 0, 1); PG8_STAGE(PG8_SB(0, 0), b2, voffB);
            PG8_BAR; PG8_WAIT_L(0); PG8_MMA(0, 1, At, B1); PG8_BAR;
            PG8_LDA(At, 0, 1); PG8_STAGE(PG8_SA(0, 0), a2, voffA);
            PG8_BAR; PG8_WAIT_L(0); PG8_MMA(1, 0, At, B0); PG8_BAR; PG8_SCHED;
            PG8_STAGE(PG8_SB(0, 1), b2 + hstep, voffB);
            PG8_WAIT_V(6); PG8_BAR; PG8_MMA(1, 1, At, B1); PG8_BAR;
            PG8_LDB(B0, 1, 0); PG8_SCHED; PG8_LDA(At, 1, 0); PG8_STAGE(PG8_SA(0, 1), a2 + hstep, voffA);
            PG8_WAIT_L(8); PG8_BAR; PG8_WAIT_L(0); PG8_MMA(0, 0, At, B0); PG8_BAR; PG8_SCHED;
            PG8_LDB(B1, 1, 1); PG8_STAGE(PG8_SB(1, 0), b3, voffB);
            PG8_BAR; PG8_WAIT_L(0); PG8_MMA(0, 1, At, B1); PG8_BAR;
            PG8_LDA(At, 1, 1); PG8_STAGE(PG8_SA(1, 0), a3, voffA);
            PG8_BAR; PG8_WAIT_L(0); PG8_MMA(1, 0, At, B0); PG8_BAR; PG8_SCHED;
            PG8_STAGE(PG8_SB(1, 1), b3 + hstep, voffB);
            PG8_WAIT_V(6); PG8_BAR; PG8_MMA(1, 1, At, B1); PG8_BAR;
            }
        }
        if constexpr (ALIGN_EPI) { if (wr == 0) PG8_BAR; }
        if constexpr (!Epi::AFTER_DRAIN) { E(acc, cur, wr, wc, fr, fq); S.done(cur); }
        if (!has_next) break;
#pragma unroll
        for (int a = 0; a < 2; ++a)
#pragma unroll
            for (int b = 0; b < 2; ++b)
#pragma unroll
                for (int m = 0; m < 4; ++m)
#pragma unroll
                    for (int n = 0; n < 2; ++n) acc[a][b][m][n] = (f32x4){0.f, 0.f, 0.f, 0.f};
        cur = nxt; cA = nA; cB = nB; ++ui;
        if constexpr (ALIGN_EPI) { if (wr == 1) PG8_BAR; }
    }
    PG8_WAIT_V(0);
    if constexpr (!ALIGN_EPI) { if (wr == 0) PG8_BAR; }
    PG8_BAR;
    if constexpr (Epi::AFTER_DRAIN) { E.fused(acc, cur, wr, wc, fr, fq, lds, wid, lane); S.done(cur); }
#undef PG8_SA
#undef PG8_SB
#undef PG8_STAGE
#undef PG8_LDA
#undef PG8_LDB
#undef PG8_MMA
#undef PG8_WAIT_V
#undef PG8_WAIT_L
#undef PG8_BAR
#undef PG8_SCHED
}
}

#define LAS __attribute__((address_space(3)))
typedef unsigned short bf16;
typedef float f32x4 __attribute__((ext_vector_type(4)));
typedef unsigned u32x4 __attribute__((ext_vector_type(4)));
typedef unsigned u32x2 __attribute__((ext_vector_type(2)));

constexpr int NWAVES = 8, NTHREADS = 512;
constexpr int BATCH = 8, SEQ = 2048, DM = 1024, NH = 16, HD = 64, FF = 4096, M = BATCH * SEQ;
constexpr int NQKV = 3072, NNSA = 2608, NNSA_PAD = 2816;
constexpr float EPS = 1e-6f;
constexpr float QSCALE = 0.125f * 1.4426950408889634f;
constexpr int NSA_KC = 1024, NSA_VC = 1280, NSA_KS = 1536, NSA_VS = 1792, NSA_KW = 2048, NSA_VW = 2304, NSA_G = 2560;
constexpr int NPH = 10, NLAYER = 4;

constexpr size_t MiB = 1u << 20;
constexpr size_t WS_CTL = 0, CTL_BYTES = 1 * MiB;
constexpr size_t WS_ROPE = 1 * MiB;
constexpr size_t WS_KSUM = 1 * MiB + 512 * 1024;
constexpr size_t WS_KCMP = 2 * MiB, WS_VCMP = 2 * MiB + 512 * 1024;
constexpr size_t WS_BIAS = 3 * MiB;
constexpr size_t WS_W = 4 * MiB, W_BUF = 28 * MiB;
constexpr size_t W_IN = 0, W_OUT = 6 * MiB, W_UP = 8 * MiB, W_DOWN = 16 * MiB, W_1K = 24 * MiB, W_1V = 25 * MiB, W_2K = 26 * MiB, W_2V = 26 * MiB + 256 * 1024;
constexpr size_t WS_XN = 60 * MiB;
constexpr size_t WS_QKV = 92 * MiB;
constexpr size_t WS_O = 188 * MiB;
constexpr size_t WS_H = 92 * MiB;
constexpr size_t WS_END = 220 * MiB;

constexpr int LDS_BYTES = 147456;
constexpr int NV_STRIDE = 12288;

#define LDSW() asm volatile("s_waitcnt lgkmcnt(0)" ::: "memory")
__device__ __forceinline__ float bf2f(bf16 v) { return __uint_as_float((unsigned)v << 16); }
__device__ __forceinline__ float bflo(unsigned w) { return __uint_as_float(w << 16); }
__device__ __forceinline__ float bfhi(unsigned w) { return __uint_as_float(w & 0xffff0000u); }
__device__ __forceinline__ unsigned f2bf(float f) { unsigned u = __float_as_uint(f); return (u + 0x7fffu + ((u >> 16) & 1u)) >> 16; }
__device__ __forceinline__ unsigned pk2(float lo, float hi) { return f2bf(lo) | (f2bf(hi) << 16); }
__device__ __forceinline__ float wave_sum(float v) {
#pragma unroll
    for (int o = 1; o < 64; o <<= 1) v += __shfl_xor(v, o);
    return v;
}
__device__ __forceinline__ float wave_max(float v) {
#pragma unroll
    for (int o = 1; o < 64; o <<= 1) v = fmaxf(v, __shfl_xor(v, o));
    return v;
}
__device__ __forceinline__ float ex2(float x) { return __builtin_amdgcn_exp2f(x); }
__device__ __forceinline__ float lg2(float x) { return __builtin_amdgcn_logf(x); }

struct Args { const float* in[39]; float* out; unsigned char* ws; int ph_lo, ph_hi; };

struct LayerPtrs { const float *g_pre, *w_in, *w_out, *g_post, *g_mlp_pre, *w_up, *w_down, *g_mlp_post, *pos_k, *w1_k, *w2_k, *pos_v, *w1_v, *w2_v; };
constexpr int PTAB_OFF = 147456 - 512;
__device__ __forceinline__ const float* ld_ptr(LAS unsigned char* lds, int i) {
    const LAS unsigned* p = (const LAS unsigned*)(lds + PTAB_OFF) + 2 * i;
    const unsigned lo = __builtin_amdgcn_readfirstlane(p[0]), hi = __builtin_amdgcn_readfirstlane(p[1]);
    return (const float*)(((unsigned long long)hi << 32) | lo);
}
__device__ __forceinline__ LayerPtrs layer_ptrs(LAS unsigned char* lds, int L) {
    LayerPtrs p;
    const int base = (L == 0) ? 1 : (L == 1) ? 9 : (L == 2) ? 17 : 31; const int o = (L == 2) ? 6 : 0;
    p.g_pre = ld_ptr(lds, base); p.w_in = ld_ptr(lds, base + 1);
    p.pos_k = ld_ptr(lds, 19); p.w1_k = ld_ptr(lds, 20); p.w2_k = ld_ptr(lds, 21); p.pos_v = ld_ptr(lds, 22); p.w1_v = ld_ptr(lds, 23); p.w2_v = ld_ptr(lds, 24);
    p.w_out = ld_ptr(lds, base + 2 + o); p.g_post = ld_ptr(lds, base + 3 + o); p.g_mlp_pre = ld_ptr(lds, base + 4 + o); p.w_up = ld_ptr(lds, base + 5 + o); p.w_down = ld_ptr(lds, base + 6 + o); p.g_mlp_post = ld_ptr(lds, base + 7 + o);
    return p;
}

struct Frame {
    LAS unsigned char* lds; int tid, lane, wave, G, gw, ngw;
    unsigned char* ws; float* xres;
};

__device__ __forceinline__ void conv_item(const float* W, int K, int N, bf16* WT, LAS float* scr, int item, int nblk, int lane) {
    const int kb = item / nblk, nb = item % nblk, k0 = 64 * kb, n0 = 32 * nb;
    const int n = n0 + (lane & 31);
#pragma unroll 8
    for (int i = 0; i < 32; ++i) { const int kk = 2 * i + (lane >> 5); scr[kk * 33 + (lane & 31)] = (n < N) ? W[(size_t)(k0 + kk) * N + n] : 0.f; }
    LDSW();
    const int c = lane & 7;
#pragma unroll
    for (int j = 0; j < 4; ++j) { const int nn = (lane >> 3) + 8 * j; const LAS float* s = scr + (8 * c) * 33 + nn;
        u32x4 o; o.x = pk2(s[0 * 33], s[1 * 33]); o.y = pk2(s[2 * 33], s[3 * 33]); o.z = pk2(s[4 * 33], s[5 * 33]); o.w = pk2(s[6 * 33], s[7 * 33]);
        *(u32x4*)(WT + (size_t)(n0 + nn) * K + k0 + 8 * c) = o; }
    LDSW();
}
__device__ __forceinline__ void phase_conv(Frame& F, int L) {
    const LayerPtrs P = layer_ptrs(F.lds, L); const int kind = L % 3;
    LAS float* scr = (LAS float*)(F.lds + F.wave * NV_STRIDE);
    unsigned char* wb = F.ws + WS_W + (size_t)(L & 1) * W_BUF;
    const int npad_in = (kind == 2) ? NNSA_PAD : NQKV, n_in = (kind == 2) ? NNSA : NQKV;
    const int I_IN = (DM / 64) * (npad_in / 32), I_OUT = (DM / 64) * (DM / 32), I_UP = (DM / 64) * (FF / 32), I_DN = (FF / 64) * (DM / 32);
    const int NIT = I_IN + I_OUT + I_UP + I_DN;
    for (int it = F.gw; it < NIT; it += F.ngw) {
        int r = it;
        if (r < I_IN) { conv_item(P.w_in, DM, n_in, (bf16*)(wb + W_IN), scr, r, npad_in / 32, F.lane); continue; } r -= I_IN;
        if (r < I_OUT) { conv_item(P.w_out, DM, DM, (bf16*)(wb + W_OUT), scr, r, DM / 32, F.lane); continue; } r -= I_OUT;
        if (r < I_UP) { conv_item(P.w_up, DM, FF, (bf16*)(wb + W_UP), scr, r, FF / 32, F.lane); continue; } r -= I_UP;
        conv_item(P.w_down, FF, DM, (bf16*)(wb + W_DOWN), scr, r, DM / 32, F.lane);
    }
    if (kind == 2) {
        const int I_1 = (2048 / 64) * (256 / 32), I_2 = (256 / 64) * (64 / 32);
        for (int it = F.gw; it < 2 * (I_1 + I_2); it += F.ngw) {
            const int kv = it / (I_1 + I_2); int r = it % (I_1 + I_2);
            if (r < I_1) conv_item(kv ? P.w1_v : P.w1_k, 2048, 256, (bf16*)(wb + (kv ? W_1V : W_1K)), scr, r, 256 / 32, F.lane);
            else conv_item(kv ? P.w2_v : P.w2_k, 256, 64, (bf16*)(wb + (kv ? W_2V : W_2K)), scr, r - I_1, 64 / 32, F.lane);
        }
        float* bias = (float*)(F.ws + WS_BIAS);
        for (int it = F.gw; it < 512; it += F.ngw) {
            const int kv = it >> 8, n = it & 255; const float* pos = kv ? P.pos_v : P.pos_k; const float* w1 = kv ? P.w1_v : P.w1_k; float s = 0.f;
            for (int kk = F.lane; kk < 2048; kk += 64) s += pos[kk] * w1[(size_t)kk * 256 + n];
            s = wave_sum(s); if (F.lane == 0) bias[it] = s;
        }
    }
    if (L == 0) {
        float2* tab = (float2*)(F.ws + WS_ROPE);
        for (int e = F.gw * 64 + F.lane; e < SEQ * 32; e += F.ngw * 64) {
            const int t = e >> 5, i = e & 31;
            double pw = 1.0; for (int k = 0; k < i; ++k) pw *= 1.333521432163324;
            const float pwf = (float)pw; const float inv = 1.0f / pwf; const float ang = (float)t * inv;
            const double x = (double)ang; const double nrev = __builtin_rint(x * 0.15915494309189535); const double r = x - nrev * 6.283185307179586;
            const double r2 = r * r; double cs = 1.0, sn = r, tc = 1.0, tsn = r;
#pragma unroll 1
            for (int k = 1; k <= 14; ++k) { tc *= -r2 / (double)((2 * k - 1) * (2 * k)); tsn *= -r2 / (double)((2 * k) * (2 * k + 1)); cs += tc; sn += tsn; }
            tab[e] = make_float2((float)cs, (float)sn);
        }
        const float* x = ld_ptr(F.lds, 0); bf16* XN = (bf16*)(F.ws + WS_XN);
        f32x4 g[4];
#pragma unroll
        for (int j = 0; j < 4; ++j) g[j] = *((const f32x4*)P.g_pre + F.lane + 64 * j);
        for (int m = F.gw; m < M; m += F.ngw) {
            const f32x4* xr = (const f32x4*)(x + (size_t)m * DM) + F.lane; f32x4 v[4]; float ss = 0.f;
#pragma unroll
            for (int j = 0; j < 4; ++j) { v[j] = xr[64 * j]; ss += (v[j].x * v[j].x + v[j].y * v[j].y) + (v[j].z * v[j].z + v[j].w * v[j].w); }
            const float r = 1.0f / sqrtf(wave_sum(ss) * (1.f / DM) + EPS);
            f32x4* xo = (f32x4*)(F.xres + (size_t)m * DM) + F.lane; u32x2* o8 = (u32x2*)(XN + (size_t)m * DM) + F.lane;
#pragma unroll
            for (int j = 0; j < 4; ++j) { xo[64 * j] = v[j]; u32x2 w; w.x = pk2(v[j].x * r * g[j].x, v[j].y * r * g[j].y); w.y = pk2(v[j].z * r * g[j].z, v[j].w * r * g[j].w); o8[64 * j] = w; }
        }
    }
}

__device__ __forceinline__ void phase_rope(Frame& F, int kind) {
    const float2* tab = (const float2*)(F.ws + WS_ROPE);
    const int np = (kind == 2) ? NNSA_PAD : NQKV; bf16* QKV = (bf16*)(F.ws + WS_QKV);
    for (int m = F.gw; m < M; m += F.ngw) {
        bf16* row = QKV + (size_t)m * np; const int t = m % SEQ;
        if (kind == 1) {
#pragma unroll
            for (int j = 0; j < 16; ++j) { const int c = j * 64 + F.lane; row[c] = (bf16)f2bf(bf2f(row[c]) * QSCALE); }
        } else {
            const int i = F.lane & 31; const float2 cs = tab[t * 32 + i];
            const int nit = (kind == 0) ? 16 : 18;
            for (int it = 0; it < nit; ++it) {
                const int slot = 2 * it + (F.lane >> 5);
                const bool roped = (kind == 0) ? true : (slot < 20 || (slot >= 24 && slot < 28) || (slot >= 32 && slot < 36));
                if (roped) { const float sc = slot < 16 ? QSCALE : 1.0f; bf16* p = row + slot * 64 + i;
                    const float x1 = bf2f(p[0]), x2 = bf2f(p[32]);
                    p[0] = (bf16)f2bf((x1 * cs.x - x2 * cs.y) * sc); p[32] = (bf16)f2bf((x1 * cs.y + x2 * cs.x) * sc); }
            }
        }
    }
}
__device__ __forceinline__ void phase_ksum(Frame& F) {
    const bf16* QKV = (const bf16*)(F.ws + WS_QKV); float* ksum = (float*)(F.ws + WS_KSUM);
    for (int it = F.gw; it < BATCH * 8 * 16; it += F.ngw) {
        const int bn = it >> 4, cc = it & 15; const bf16* p = QKV + (size_t)(bn * 256) * NQKV + 1024 + cc * 64 + F.lane; float s = 0.f;
#pragma unroll 8
        for (int r = 0; r < 256; ++r) s += bf2f(p[(size_t)r * NQKV]);
        ksum[bn * 1024 + cc * 64 + F.lane] = s;
    }
}
__device__ __forceinline__ void phase_norm(Frame& F, const float* ga, const float* gb) {
    bf16* XN = (bf16*)(F.ws + WS_XN);
    f32x4 g1[4], g2[4];
#pragma unroll
    for (int j = 0; j < 4; ++j) { g1[j] = *((const f32x4*)ga + F.lane + 64 * j); g2[j] = gb ? *((const f32x4*)gb + F.lane + 64 * j) : (f32x4){0.f, 0.f, 0.f, 0.f}; }
    for (int m = F.gw; m < M; m += F.ngw) {
        u32x2* y8 = (u32x2*)(XN + (size_t)m * DM) + F.lane; f32x4* xr = (f32x4*)(F.xres + (size_t)m * DM) + F.lane;
        f32x4 y[4], x[4]; float ss = 0.f;
#pragma unroll
        for (int j = 0; j < 4; ++j) { const u32x2 w = y8[64 * j]; y[j] = (f32x4){bflo(w.x), bfhi(w.x), bflo(w.y), bfhi(w.y)}; x[j] = xr[64 * j];
            ss += (y[j].x * y[j].x + y[j].y * y[j].y) + (y[j].z * y[j].z + y[j].w * y[j].w); }
        const float r = 1.0f / sqrtf(wave_sum(ss) * (1.f / DM) + EPS); float s2 = 0.f;
#pragma unroll
        for (int j = 0; j < 4; ++j) { x[j] = x[j] + y[j] * r * g1[j]; xr[64 * j] = x[j]; s2 += (x[j].x * x[j].x + x[j].y * x[j].y) + (x[j].z * x[j].z + x[j].w * x[j].w); }
        if (gb) { const float r2 = 1.0f / sqrtf(wave_sum(s2) * (1.f / DM) + EPS);
#pragma unroll
            for (int j = 0; j < 4; ++j) { u32x2 w; w.x = pk2(x[j].x * r2 * g2[j].x, x[j].y * r2 * g2[j].y); w.y = pk2(x[j].z * r2 * g2[j].z, x[j].w * r2 * g2[j].w); y8[64 * j] = w; } }
    }
}

struct NvScr { LAS float* sc; LAS int* kp; LAS float* qs; LAS float* imp; LAS int* seg; LAS float* hid; };
__device__ __forceinline__ NvScr nv_scr(LAS unsigned char* lds, int wave) {
    LAS unsigned char* b = lds + wave * NV_STRIDE; NvScr s;
    s.sc = (LAS float*)b; s.kp = (LAS int*)(b + 4352); s.qs = (LAS float*)(b + 8704); s.imp = (LAS float*)(b + 8960); s.seg = (LAS int*)(b + 9088); s.hid = (LAS float*)(b + 9344); return s;
}
__device__ __forceinline__ float nv_dot(const bf16* kr, LAS float* qs) {
    float s = 0.f;
#pragma unroll
    for (int c = 0; c < 8; ++c) { const u32x4 w = *(const u32x4*)(kr + 8 * c);
        s += qs[8 * c + 0] * bflo(w.x) + qs[8 * c + 1] * bfhi(w.x) + qs[8 * c + 2] * bflo(w.y) + qs[8 * c + 3] * bfhi(w.y)
           + qs[8 * c + 4] * bflo(w.z) + qs[8 * c + 5] * bfhi(w.z) + qs[8 * c + 6] * bflo(w.w) + qs[8 * c + 7] * bfhi(w.w); }
    return s;
}
__device__ __forceinline__ float nv_attend(const bf16* Kb, const bf16* Vb, int pitch, const NvScr& S, int nseg, int lane, int& n_out) {
    int n = 0;
    for (int i = 0; i < nseg; ++i) { const int st = S.seg[2 * i], ln = S.seg[2 * i + 1]; for (int k = lane; k < ln; k += 64) S.kp[n + k] = st + k; n += ln; }
    LDSW();
    float mx = -INFINITY;
    for (int k = lane; k < n; k += 64) { const float s = nv_dot(Kb + (size_t)S.kp[k] * pitch, S.qs); S.sc[k] = s; mx = fmaxf(mx, s); }
    mx = wave_max(mx);
    float l = 0.f;
    for (int k = lane; k < n; k += 64) { const float p = ex2(S.sc[k] - mx); S.sc[k] = p; l += p; }
    l = wave_sum(l);
    const float inv = (n > 0) ? 1.0f / l : 0.f;
    for (int k = lane; k < n; k += 64) S.sc[k] *= inv;
    LDSW();
    float o = 0.f;
#pragma unroll 4
    for (int k = 0; k < n; ++k) o += S.sc[k] * bf2f(Vb[(size_t)S.kp[k] * pitch + lane]);
    n_out = n;
    return o;
}

__device__ __forceinline__ void phase_moba_simple(Frame& F) {
    const NvScr S = nv_scr(F.lds, F.wave); const int lane = F.lane;
    const bf16* QKV = (const bf16*)(F.ws + WS_QKV); bf16* O = (bf16*)(F.ws + WS_O); const float* ksum = (const float*)(F.ws + WS_KSUM);
    for (int item = F.gw; item < BATCH * NH * SEQ; item += F.ngw) {
        const int b = item / (NH * SEQ), h = (item / SEQ) % NH, t = item % SEQ, m = b * SEQ + t, qblk = t >> 8;
        const float qd = bf2f(QKV[(size_t)m * NQKV + h * 64 + lane]);
        S.qs[lane] = qd;
        unsigned selmask;
        if (qblk <= 3) selmask = (1u << qblk) - 1u;
        else {
            float gv = -INFINITY;
            for (int n = 0; n < qblk; ++n) { const float g = wave_sum(qd * ksum[(b * 8 + n) * 1024 + h * 64 + lane]); if (lane == n) gv = g; }
            int rank = 0;
            for (int n = 0; n < qblk; ++n) { const float gp = __shfl(gv, n); rank += ((gp > gv) || (gp == gv && n < lane)) ? 1 : 0; }
            selmask = (unsigned)__ballot(lane < qblk && rank < 3);
        }
        if (lane == 0) { int ns = 0; S.seg[0] = b * SEQ + 256 * qblk; S.seg[1] = t - 256 * qblk + 1; ns = 1;
            for (int n = 0; n < 8; ++n) if ((selmask >> n) & 1u) { S.seg[2 * ns] = b * SEQ + 256 * n; S.seg[2 * ns + 1] = 256; ++ns; } }
        LDSW();
        const int nseg = 1 + __popc(selmask); int nk;
        const float o = nv_attend(QKV + 1024 + h * 64, QKV + 2048 + h * 64, NQKV, S, nseg, lane, nk);
        O[(size_t)m * DM + h * 64 + lane] = (bf16)f2bf(o);
        LDSW();
    }
}

__device__ __forceinline__ void phase_sb_simple(Frame& F) {
    const NvScr S = nv_scr(F.lds, F.wave); const int lane = F.lane;
    const bf16* QKV = (const bf16*)(F.ws + WS_QKV); bf16* O = (bf16*)(F.ws + WS_O);
    for (int item = F.gw; item < BATCH * NH * SEQ; item += F.ngw) {
        const int b = item / (NH * SEQ), h = (item / SEQ) % NH, t = item % SEQ, m = b * SEQ + t;
        S.qs[lane] = bf2f(QKV[(size_t)m * NQKV + h * 64 + lane]);
        LDSW();
        const bf16* Kb = QKV + (size_t)(b * SEQ) * NQKV + 1024 + h * 64; const bf16* Vb = QKV + (size_t)(b * SEQ) * NQKV + 2048 + h * 64 + lane;
        float o = 0.f, carry = 0.f;
        for (int base = t - 1; base >= 0; base -= 64) {
            const int pos = base - lane; const bool valid = pos >= 0;
            const float z = valid ? nv_dot(Kb + (size_t)pos * NQKV, S.qs) : 0.f;
            const float lb = fminf(z, 0.f) - lg2(1.0f + ex2(-fabsf(z)));
            const float l1 = valid ? lb - z : 0.f;
            float incl = l1;
#pragma unroll
            for (int o2 = 1; o2 < 64; o2 <<= 1) { const float v = __shfl_up(incl, o2); if (lane >= o2) incl += v; }
            const float total = __shfl(incl, 63);
            const float w = valid ? ex2(lb + carry + (incl - l1)) : 0.f;
            S.sc[lane] = w; LDSW();
            const int nk = base + 1 < 64 ? base + 1 : 64;
#pragma unroll 4
            for (int i = 0; i < nk; ++i) o += S.sc[i] * bf2f(Vb[(size_t)(base - i) * NQKV]);
            carry += total; LDSW();
            if (carry < -150.f) break;
        }
        O[(size_t)m * DM + h * 64 + lane] = (bf16)f2bf(o);
    }
}

__device__ __forceinline__ float gelu_tanh(float x) { const float u = 0.7978845608028654f * (x + 0.044715f * x * x * x); return 0.5f * x * (1.0f + tanhf(u)); }
__device__ __forceinline__ void phase_compress_simple(Frame& F, const LayerPtrs& P) {
    const NvScr S = nv_scr(F.lds, F.wave); const int lane = F.lane;
    const bf16* QKV = (const bf16*)(F.ws + WS_QKV);
    for (int item = F.gw; item < 2 * 32 * 128; item += F.ngw) {
        const int kv = item / (32 * 128), bg = (item / 128) % 32, c = item % 128, b = bg >> 2, g = bg & 3;
        bf16* out = (bf16*)(F.ws + (kv ? WS_VCMP : WS_KCMP)) + (size_t)(bg * 128 + c) * 64;
        if (c == 127) { out[lane] = 0; continue; }
        const float* pos = kv ? P.pos_v : P.pos_k; const float* w1 = kv ? P.w1_v : P.w1_k; const float* w2 = kv ? P.w2_v : P.w2_k;
        const int colbase = (kv ? NSA_VC : NSA_KC) + g * 64;
        f32x4 acc = {0.f, 0.f, 0.f, 0.f};
        for (int l = 0; l < 32; ++l) {
            const float av = bf2f(QKV[(size_t)(b * SEQ + 16 * c + l) * NNSA_PAD + colbase + lane]) + pos[l * 64 + lane];
#pragma unroll 8
            for (int d = 0; d < 64; ++d) { const float a = __shfl(av, d); const f32x4 w = *((const f32x4*)(w1 + (size_t)(l * 64 + d) * 256) + lane); acc += a * w; }
        }
        S.hid[4 * lane + 0] = gelu_tanh(acc.x); S.hid[4 * lane + 1] = gelu_tanh(acc.y); S.hid[4 * lane + 2] = gelu_tanh(acc.z); S.hid[4 * lane + 3] = gelu_tanh(acc.w);
        LDSW();
        float o = 0.f;
#pragma unroll 8
        for (int n = 0; n < 256; ++n) o += S.hid[n] * w2[n * 64 + lane];
        out[lane] = (bf16)f2bf(o);
        LDSW();
    }
}

__device__ __forceinline__ void phase_nsa_simple(Frame& F) {
    const NvScr S = nv_scr(F.lds, F.wave); const int lane = F.lane;
    const bf16* QKV = (const bf16*)(F.ws + WS_QKV); bf16* O = (bf16*)(F.ws + WS_O);
    for (int item = F.gw; item < BATCH * 4 * SEQ; item += F.ngw) {
        const int b = item / (4 * SEQ), g = (item / SEQ) & 3, t = item % SEQ, m = b * SEQ + t, qb = t >> 6;
        const bf16* row = QKV + (size_t)m * NNSA_PAD;
        const bf16* Kc = (const bf16*)(F.ws + WS_KCMP) + (size_t)(b * 4 + g) * 128 * 64; const bf16* Vc = (const bf16*)(F.ws + WS_VCMP) + (size_t)(b * 4 + g) * 128 * 64;
        if (lane < 32) S.imp[lane] = 0.f;
        const int ncmp = t >= 31 ? ((t - 31) >> 4) + 1 : 0;
        float ocmp[4];
#pragma unroll
        for (int hh = 0; hh < 4; ++hh) {
            S.qs[lane] = bf2f(row[(4 * g + hh) * 64 + lane]);
            if (lane == 0) { S.seg[0] = 0; S.seg[1] = ncmp; }
            LDSW();
            int nk; ocmp[hh] = nv_attend(Kc, Vc, 64, S, ncmp > 0 ? 1 : 0, lane, nk);
            if (lane < 32) { const int c0 = 4 * lane; float a = 0.f;
                if (c0 - 1 >= 0 && c0 - 1 < ncmp) a += 0.5f * S.sc[c0 - 1];
                if (c0 < ncmp) a += S.sc[c0]; if (c0 + 1 < ncmp) a += S.sc[c0 + 1]; if (c0 + 2 < ncmp) a += S.sc[c0 + 2];
                if (c0 + 3 < ncmp) a += 0.5f * S.sc[c0 + 3];
                S.imp[lane] += a; }
            LDSW();
        }
        unsigned selmask;
        if (qb < 16) selmask = (1u << (qb + 1)) - 1u;
        else {
            const int j = lane & 31; const float vj = S.imp[j]; int rank = 0;
            for (int jp = 1; jp <= qb - 2; ++jp) { const float vp = S.imp[jp]; rank += ((vp > vj) || (vp == vj && jp < j)) ? 1 : 0; }
            const bool forced = (j == 0) || (j == qb) || (j == qb - 1); const bool cand = (j >= 1) && (j <= qb - 2);
            selmask = (unsigned)__ballot(lane < 32 && (forced || (cand && rank < 13)));
        }
#pragma unroll
        for (int hh = 0; hh < 4; ++hh) {
            const int head = 4 * g + hh;
            S.qs[lane] = bf2f(row[head * 64 + lane]);
            if (lane == 0) { int ns = 0; for (int j = 0; j <= qb; ++j) if ((selmask >> j) & 1u) { S.seg[2 * ns] = b * SEQ + 64 * j; S.seg[2 * ns + 1] = (j < qb) ? 64 : (t - 64 * qb + 1); ++ns; } }
            LDSW();
            int nk; const float oslc = nv_attend(QKV + NSA_KS + g * 64, QKV + NSA_VS + g * 64, NNSA_PAD, S, __popc(selmask), lane, nk);
            LDSW();
            const int w0 = t - 511 > 0 ? t - 511 : 0;
            if (lane == 0) { S.seg[0] = b * SEQ + w0; S.seg[1] = t - w0 + 1; }
            LDSW();
            const float owin = nv_attend(QKV + NSA_KW + g * 64, QKV + NSA_VW + g * 64, NNSA_PAD, S, 1, lane, nk);
            const float g0 = 1.0f / (1.0f + __expf(-bf2f(row[NSA_G + head * 3 + 0]))), g1 = 1.0f / (1.0f + __expf(-bf2f(row[NSA_G + head * 3 + 1]))), g2 = 1.0f / (1.0f + __expf(-bf2f(row[NSA_G + head * 3 + 2])));
            O[(size_t)m * DM + head * 64 + lane] = (bf16)f2bf(g0 * ocmp[hh] + g1 * oslc + g2 * owin);
            LDSW();
        }
    }
}


namespace fa {
typedef short bf16x8 __attribute__((ext_vector_type(8)));
typedef short s16x4 __attribute__((ext_vector_type(4)));
typedef short v4i16_t __attribute__((ext_vector_type(4)));
typedef float f32x16 __attribute__((ext_vector_type(16)));
constexpr int SLOTB = 8192;
constexpr int L_K = 0, L_V = 16384, L_WS = 32768, L_OST = 34816, L_MISC = 67584, L_IMP = 69632;
constexpr float THR = 8.f;
__device__ __forceinline__ int crow(int r, int hi) { return (r & 3) + 8 * (r >> 2) + 4 * hi; }
typedef float f32x2_t __attribute__((ext_vector_type(2))); typedef __bf16 bf16x2_t __attribute__((ext_vector_type(2)));
__device__ __forceinline__ unsigned cvtpk(float lo, float hi) { f32x2_t v = {lo, hi}; bf16x2_t b = __builtin_convertvector(v, bf16x2_t); return __builtin_bit_cast(unsigned, b); }
__device__ __forceinline__ f32x16 splat(float v) { f32x16 r;
#pragma unroll
    for (int i = 0; i < 16; ++i) r[i] = v;
    return r; }
__device__ __forceinline__ float half_sum(float v) { auto rr = __builtin_amdgcn_permlane32_swap(__float_as_uint(v), __float_as_uint(v), false, false); return __uint_as_float(rr[0]) + __uint_as_float(rr[1]); }
__device__ __forceinline__ float half_max(float v) { auto rr = __builtin_amdgcn_permlane32_swap(__float_as_uint(v), __float_as_uint(v), false, false); return fmaxf(__uint_as_float(rr[0]), __uint_as_float(rr[1])); }

struct TileRegs { u32x4 k, v; };
__device__ __forceinline__ TileRegs tile_load(const bf16* Kg, const bf16* Vg, int pitch, int row0, int wave, int lane) {
    TileRegs t;
    t.k = *(const u32x4*)(Kg + (size_t)(row0 + lane) * pitch + wave * 8);
    t.v = *(const u32x4*)(Vg + (size_t)(row0 + 16 * (wave & 3) + (lane >> 2)) * pitch + (wave >> 2) * 32 + (lane & 3) * 8);
    return t;
}
__device__ __forceinline__ void tile_store(LAS unsigned char* lds, int slot, const TileRegs& t, int tid) {
    *(LAS u32x4*)(lds + L_K + slot * SLOTB + tid * 16) = t.k; *(LAS u32x4*)(lds + L_V + slot * SLOTB + tid * 16) = t.v;
}
__device__ __forceinline__ void qkt(f32x16& p0, f32x16& p1, const LAS unsigned char* Ks, const bf16x8 (&qr)[4], const f32x16& c, int r32, int hi) {
    const LAS unsigned char* kb = Ks + hi * 1024 + r32 * 16;
#pragma unroll
    for (int d0 = 0; d0 < 4; ++d0) {
        const bf16x8 b0 = *(const LAS bf16x8*)(kb + d0 * 2048), b1 = *(const LAS bf16x8*)(kb + d0 * 2048 + 512);
        if (d0 == 0) { p0 = __builtin_amdgcn_mfma_f32_32x32x16_bf16(b0, qr[0], c, 0, 0, 0); p1 = __builtin_amdgcn_mfma_f32_32x32x16_bf16(b1, qr[0], c, 0, 0, 0); }
        else { p0 = __builtin_amdgcn_mfma_f32_32x32x16_bf16(b0, qr[d0], p0, 0, 0, 0); p1 = __builtin_amdgcn_mfma_f32_32x32x16_bf16(b1, qr[d0], p1, 0, 0, 0); }
    }
}
__device__ __forceinline__ s16x4 vtr(const LAS unsigned char* p) { return __builtin_bit_cast(s16x4, __builtin_amdgcn_ds_read_tr16_b64_v4i16((LAS v4i16_t*)p)); }
__device__ __forceinline__ void pv(f32x16 (&o)[2], const LAS unsigned char* vp, const u32x4 (&pa)[4]) {
#pragma unroll
    for (int d0 = 0; d0 < 2; ++d0)
#pragma unroll
        for (int ks = 0; ks < 4; ++ks) {
            const s16x4 lo = vtr(vp + d0 * 4096 + ks * 1024), hh = vtr(vp + d0 * 4096 + ks * 1024 + 512);
            const bf16x8 vf = (bf16x8){lo[0], lo[1], lo[2], lo[3], hh[0], hh[1], hh[2], hh[3]};
            o[d0] = __builtin_amdgcn_mfma_f32_32x32x16_bf16(__builtin_bit_cast(bf16x8, pa[ks]), vf, o[d0], 0, 0, 0);
        }
}
__device__ __forceinline__ void pack_p(u32x4 (&pa)[4], const f32x16& p0, const f32x16& p1) {
    pa[0] = (u32x4){cvtpk(p0[0], p0[1]), cvtpk(p0[2], p0[3]), cvtpk(p0[4], p0[5]), cvtpk(p0[6], p0[7])};
    pa[1] = (u32x4){cvtpk(p0[8], p0[9]), cvtpk(p0[10], p0[11]), cvtpk(p0[12], p0[13]), cvtpk(p0[14], p0[15])};
    pa[2] = (u32x4){cvtpk(p1[0], p1[1]), cvtpk(p1[2], p1[3]), cvtpk(p1[4], p1[5]), cvtpk(p1[6], p1[7])};
    pa[3] = (u32x4){cvtpk(p1[8], p1[9]), cvtpk(p1[10], p1[11]), cvtpk(p1[12], p1[13]), cvtpk(p1[14], p1[15])};
}
__device__ __forceinline__ float rowmax(const f32x16& p0, const f32x16& p1) {
    float a = fmaxf(p0[0], p1[0]), b = fmaxf(p0[1], p1[1]);
#pragma unroll
    for (int r = 2; r < 16; r += 2) { a = fmaxf(a, fmaxf(p0[r], p1[r])); b = fmaxf(b, fmaxf(p0[r + 1], p1[r + 1])); }
    return half_max(fmaxf(a, b));
}
__device__ __forceinline__ void cmask(f32x16& p0, f32x16& p1, int ll, int hl, int hi) {
#pragma unroll
    for (int r = 0; r < 16; ++r) { const int kv = crow(r, hi); if (kv < ll || kv > hl) p0[r] = -INFINITY; if (kv + 32 < ll || kv + 32 > hl) p1[r] = -INFINITY; }
}
struct SmState { f32x16 o[2]; float mhat, l; };
__device__ __forceinline__ void sm_reset(SmState& s) { s.o[0] = splat(0.f); s.o[1] = splat(0.f); s.mhat = 0.f; s.l = 0.f; }
__device__ __forceinline__ void sm_tile(const LAS unsigned char* Ks, const LAS unsigned char* Vs, const bf16x8 (&qr)[4], SmState& st, float cin, bool first, bool domask, int ll, int hl,
                                        LAS float* wsf, int r32, int hi, int lane) {
    f32x16 p0, p1;
    { const f32x16 c = splat(cin); qkt(p0, p1, Ks, qr, c, r32, hi); }
    if (domask) cmask(p0, p1, ll, hl, hi);
    const float rm = rowmax(p0, p1);
    if (first || __any(rm > THR)) {
        const float dl = first ? ((rm > -INFINITY) ? rm : 0.f) : fmaxf(rm, 0.f);
        st.mhat += dl;
#pragma unroll
        for (int r = 0; r < 16; ++r) { p0[r] -= dl; p1[r] -= dl; }
        if (!first) {
            const float f = ex2(-dl); st.l *= f;
            if (hi == 0) wsf[r32] = f;
            LDSW();
#pragma unroll
            for (int r = 0; r < 16; ++r) { const float fr = wsf[crow(r, hi)]; st.o[0][r] *= fr; st.o[1][r] *= fr; }
            LDSW();
        }
    }
    float s = 0.f;
#pragma unroll
    for (int r = 0; r < 16; ++r) { p0[r] = ex2(p0[r]); p1[r] = ex2(p1[r]); s += p0[r] + p1[r]; }
    st.l += s;
    u32x4 pa[4]; pack_p(pa, p0, p1);
    const LAS unsigned char* vp = Vs + ((lane >> 4) & 1) * 32 + (lane & 3) * 8 + (4 * hi + ((lane & 15) >> 2)) * 64;
    pv(st.o, vp, pa);
}
template <bool ACCUM> __device__ __forceinline__ void scale_rows(f32x16 (&acc)[2], const f32x16 (&o)[2], float fac, LAS float* wsf, int r32, int hi) {
    if (hi == 0) wsf[32 + r32] = fac;
    LDSW();
#pragma unroll
    for (int r = 0; r < 16; ++r) { const float f = wsf[32 + crow(r, hi)];
        if (ACCUM) { acc[0][r] += o[0][r] * f; acc[1][r] += o[1][r] * f; } else { acc[0][r] = o[0][r] * f; acc[1][r] = o[1][r] * f; } }
    LDSW();
}
__device__ __forceinline__ void store_rows(const f32x16 (&o)[2], bf16* Ow, LAS unsigned char* lds, int wave, int lane, int r32, int hi) {
    LAS bf16* stg = (LAS bf16*)(lds + L_OST + wave * 4096);
#pragma unroll
    for (int r = 0; r < 16; ++r) { const int orow = crow(r, hi);
#pragma unroll
        for (int d0 = 0; d0 < 2; ++d0) stg[orow * 64 + d0 * 32 + r32] = (bf16)f2bf(o[d0][r]); }
    LDSW();
#pragma unroll
    for (int i = 0; i < 4; ++i) { const int row = i * 8 + (lane >> 3), ch = lane & 7; const u32x4 v = *(const LAS u32x4*)(stg + row * 64 + ch * 8); *(u32x4*)(Ow + (size_t)row * DM + ch * 8) = v; }
    LDSW();
}
__device__ __forceinline__ float bfe(const bf16x8& v, int j) { return __uint_as_float(((unsigned)(unsigned short)v[j]) << 16); }

__device__ __forceinline__ int moba_tile(int idx, int qb, unsigned uni) {
    if (idx < 4) return 4 * qb + idx;
    int k = (idx - 4) >> 2; unsigned u = uni;
    for (int i = 0; i < k; ++i) u &= u - 1u;
    return 4 * (__ffs((int)u) - 1) + ((idx - 4) & 3);
}
__device__ __forceinline__ void moba_unit(LAS unsigned char* lds, const bf16* QKV, const float* ksum, bf16* O, int b, int h, int qb, int tid) {
    const int lane = tid & 63, w = __builtin_amdgcn_readfirstlane(tid >> 6), r32 = lane & 31, hi = lane >> 5;
    const int rowbase = b * SEQ, q0 = 256 * qb;
    const bf16* Qw = QKV + (size_t)(rowbase + q0 + 32 * w + r32) * NQKV + h * 64;
    const bf16* Kg = QKV + 1024 + h * 64; const bf16* Vg = QKV + 2048 + h * 64;
    LAS float* wsf = (LAS float*)(lds + L_WS) + w * 64;
    LAS unsigned* misc = (LAS unsigned*)(lds + L_MISC);
    bf16x8 qr[4];
#pragma unroll
    for (int d0 = 0; d0 < 4; ++d0) qr[d0] = *(const bf16x8*)(Qw + d0 * 16 + hi * 8);
    unsigned sel;
    if (qb <= 3) sel = (1u << qb) - 1u;
    else {
        float g[7];
#pragma unroll
        for (int n = 0; n < 7; ++n) {
            g[n] = -INFINITY;
            if (n < qb) { const float* kp = ksum + (size_t)(b * 8 + n) * 1024 + h * 64 + hi * 8; float s = 0.f;
#pragma unroll
                for (int d0 = 0; d0 < 4; ++d0) { const f32x4 k0 = *(const f32x4*)(kp + 16 * d0), k1 = *(const f32x4*)(kp + 16 * d0 + 4);
                    s += bfe(qr[d0], 0) * k0.x + bfe(qr[d0], 1) * k0.y + bfe(qr[d0], 2) * k0.z + bfe(qr[d0], 3) * k0.w + bfe(qr[d0], 4) * k1.x + bfe(qr[d0], 5) * k1.y + bfe(qr[d0], 6) * k1.z + bfe(qr[d0], 7) * k1.w; }
                g[n] = half_sum(s); }
        }
        sel = 0u;
#pragma unroll
        for (int n = 0; n < 7; ++n) { int rank = 0;
#pragma unroll
            for (int n2 = 0; n2 < 7; ++n2) rank += ((g[n2] > g[n]) || (g[n2] == g[n] && n2 < n)) ? 1 : 0;
            if (n < qb && rank < 3) sel |= 1u << n; }
    }
    if (tid == 0) misc[0] = 0u;
    __syncthreads();
    { unsigned wsel = 0u;
#pragma unroll
      for (int n = 0; n < 7; ++n) if (__any((sel >> n) & 1u)) wsel |= 1u << n;
      if (lane == 0) __hip_atomic_fetch_or(misc, wsel, __ATOMIC_RELAXED, __HIP_MEMORY_SCOPE_WORKGROUP); }
    __syncthreads();
    const unsigned uni = misc[0];
    const int nt = 4 + 4 * __popc(uni);
    SmState st; sm_reset(st);
    TileRegs tr = tile_load(Kg, Vg, NQKV, rowbase + 64 * (4 * qb), w, lane);
    tile_store(lds, 0, tr, tid);
    __syncthreads();
    for (int idx = 0; idx < nt; ++idx) {
        const bool more = idx + 1 < nt;
        if (more) tr = tile_load(Kg, Vg, NQKV, rowbase + 64 * moba_tile(idx + 1, qb, uni), w, lane);
        const LAS unsigned char* Ks = lds + L_K + (idx & 1) * SLOTB; const LAS unsigned char* Vs = lds + L_V + (idx & 1) * SLOTB;
        if (idx < 4) {
            if (64 * idx <= 32 * w + 31) sm_tile(Ks, Vs, qr, st, -st.mhat, idx == 0, 64 * idx + 63 > 32 * w, -1, 32 * w + r32 - 64 * idx, wsf, r32, hi, lane);
        } else {
            const int n = moba_tile(idx, qb, uni) >> 2; const bool bit = (sel >> n) & 1u;
            if (__any(bit)) sm_tile(Ks, Vs, qr, st, bit ? -st.mhat : -INFINITY, false, false, 0, 0, wsf, r32, hi, lane);
        }
        if (more) tile_store(lds, (idx & 1) ^ 1, tr, tid);
        __syncthreads();
    }
    const float lt = half_sum(st.l);
    f32x16 on[2]; scale_rows<false>(on, st.o, lt > 0.f ? 1.0f / lt : 0.f, wsf, r32, hi);
    store_rows(on, O + (size_t)(rowbase + q0 + 32 * w) * DM + h * 64, lds, w, lane, r32, hi);
}
}

__device__ __forceinline__ void phase_moba_fast(Frame& F) {
    const bf16* QKV = (const bf16*)(F.ws + WS_QKV); bf16* O = (bf16*)(F.ws + WS_O); const float* ksum = (const float*)(F.ws + WS_KSUM);
    const int bx = blockIdx.x, vcu = (bx & 7) * 32 + (bx >> 3), bal = (F.G == 256);
    const int nun = bal ? 4 : (BATCH * NH * 8 - bx + F.G - 1) / F.G;
#pragma unroll 1
    for (int i = 0; i < nun; ++i) {
        int bh, qb;
        if (bal) { bh = vcu >> 1; qb = (vcu & 1) ? (i == 0 ? 2 : i == 1 ? 5 : i == 2 ? 3 : 4) : (i == 0 ? 0 : i == 1 ? 7 : i == 2 ? 1 : 6); }
        else { const int u = bx + i * F.G; bh = u >> 3; qb = u & 7; }
        int t_ = threadIdx.x; asm volatile("" : "+v"(t_));
        fa::moba_unit(F.lds, QKV, ksum, O, bh >> 4, bh & 15, qb, t_);
    }
}
namespace fa {
__device__ __forceinline__ void sb_tile(const LAS unsigned char* Ks, const LAS unsigned char* Vs, const bf16x8 (&qr)[4], const bf16x8 (&uf)[2], f32x16 (&o)[2], float& carry, bool domask, int hl, int r32, int hi, int lane) {
    f32x16 z0, z1;
    { const f32x16 c = splat(0.f); qkt(z0, z1, Ks, qr, c, r32, hi); }
    f32x16 m0, m1;
    float t0 = 0.f, t1 = 0.f;
#pragma unroll
    for (int r = 0; r < 16; ++r) {
        const float a = z0[r], b = z1[r];
        float lba = fminf(a, 0.f) - lg2(1.0f + ex2(-fabsf(a))), lbb = fminf(b, 0.f) - lg2(1.0f + ex2(-fabsf(b)));
        float la = lba - a, lb = lbb - b;
        if (domask) { const int kv = crow(r, hi); if (kv > hl) { la = 0.f; lba = -INFINITY; } if (kv + 32 > hl) { lb = 0.f; lbb = -INFINITY; } }
        z0[r] = lba; z1[r] = lbb; m0[r] = la; m1[r] = lb; t0 += la; t1 += lb;
    }
    t0 = half_sum(t0); t1 = half_sum(t1);
    u32x4 la4[4]; pack_p(la4, m0, m1);
    f32x16 s0 = splat(carry + t1), s1 = splat(carry);
    s0 = __builtin_amdgcn_mfma_f32_32x32x16_bf16(uf[0], __builtin_bit_cast(bf16x8, la4[0]), s0, 0, 0, 0);
    s0 = __builtin_amdgcn_mfma_f32_32x32x16_bf16(uf[1], __builtin_bit_cast(bf16x8, la4[1]), s0, 0, 0, 0);
    s1 = __builtin_amdgcn_mfma_f32_32x32x16_bf16(uf[0], __builtin_bit_cast(bf16x8, la4[2]), s1, 0, 0, 0);
    s1 = __builtin_amdgcn_mfma_f32_32x32x16_bf16(uf[1], __builtin_bit_cast(bf16x8, la4[3]), s1, 0, 0, 0);
#pragma unroll
    for (int r = 0; r < 16; ++r) { z0[r] = ex2(z0[r] + s0[r]); z1[r] = ex2(z1[r] + s1[r]); }
    u32x4 pa[4]; pack_p(pa, z0, z1);
    const LAS unsigned char* vp = Vs + ((lane >> 4) & 1) * 32 + (lane & 3) * 8 + (4 * hi + ((lane & 15) >> 2)) * 64;
    pv(o, vp, pa);
    carry += t0 + t1;
}
__device__ __forceinline__ void sb_unit(LAS unsigned char* lds, const bf16* QKV, bf16* O, int b, int h, int qb, int tid) {
    const int lane = tid & 63, w = __builtin_amdgcn_readfirstlane(tid >> 6), r32 = lane & 31, hi = lane >> 5;
    const int rowbase = b * SEQ, q0 = 256 * qb;
    const bf16* Qw = QKV + (size_t)(rowbase + q0 + 32 * w + r32) * NQKV + h * 64;
    const bf16* Kg = QKV + 1024 + h * 64; const bf16* Vg = QKV + 2048 + h * 64;
    bf16x8 qr[4];
#pragma unroll
    for (int d0 = 0; d0 < 4; ++d0) qr[d0] = *(const bf16x8*)(Qw + d0 * 16 + hi * 8);
    bf16x8 uf[2];
#pragma unroll
    for (int s = 0; s < 2; ++s)
#pragma unroll
        for (int j = 0; j < 8; ++j) { const int k = 16 * s + 8 * (j >> 2) + 4 * hi + (j & 3); uf[s][j] = (k > r32) ? (short)0x3F80 : (short)0; }
    f32x16 o[2]; o[0] = splat(0.f); o[1] = splat(0.f);
    float carry = 0.f; bool done = false;
    const int nt = 4 * qb + 4;
    TileRegs tr = tile_load(Kg, Vg, NQKV, rowbase + 64 * (nt - 1), w, lane);
    tile_store(lds, 0, tr, tid);
    __syncthreads();
    for (int idx = 0; idx < nt; ++idx) {
        const int tile = nt - 1 - idx; const bool more = idx + 1 < nt;
        if (more) tr = tile_load(Kg, Vg, NQKV, rowbase + 64 * (tile - 1), w, lane);
        const LAS unsigned char* Ks = lds + L_K + (idx & 1) * SLOTB; const LAS unsigned char* Vs = lds + L_V + (idx & 1) * SLOTB;
        if (!done) {
            const int jb = tile - 4 * qb;
            if (jb >= 0) { if (64 * jb < 32 * w + 31) sb_tile(Ks, Vs, qr, uf, o, carry, 64 * jb + 64 > 32 * w, 32 * w + r32 - 64 * jb - 1, r32, hi, lane); }
            else sb_tile(Ks, Vs, qr, uf, o, carry, false, 0, r32, hi, lane);
            done = __all(carry < -150.f);
        }
        if (more) tile_store(lds, (idx & 1) ^ 1, tr, tid);
        if (!__syncthreads_or(done ? 0 : 1)) break;
    }
    store_rows(o, O + (size_t)(rowbase + q0 + 32 * w) * DM + h * 64, lds, w, lane, r32, hi);
    __syncthreads();
}

constexpr int L_SELM = L_MISC + 64, L_IMPS = 69632, L_IMPP = 77824;
__device__ __forceinline__ int nth_bit(unsigned u, int k) { for (int i = 0; i < k; ++i) u &= u - 1u; return __ffs((int)u) - 1; }
__device__ __forceinline__ float sigm(float x) { return 1.0f / (1.0f + __expf(-x)); }
__device__ __forceinline__ void nsa_unit(LAS unsigned char* lds, const bf16* QKV, const bf16* KC, const bf16* VC, bf16* O, int b, int g, int qb, int tid) {
    const int lane = tid & 63, w = __builtin_amdgcn_readfirstlane(tid >> 6), r32 = lane & 31, hi = lane >> 5;
    const int hh = w >> 1, rh = w & 1, head = 4 * g + hh, rowbase = b * SEQ, tl = 32 * rh + r32, trow = 64 * qb + tl;
    const bf16* qrow = QKV + (size_t)(rowbase + trow) * NNSA_PAD;
    LAS float* wsf = (LAS float*)(lds + L_WS) + w * 64;
    LAS unsigned* misc = (LAS unsigned*)(lds + L_MISC); LAS unsigned* selm = (LAS unsigned*)(lds + L_SELM);
    LAS float* imps = (LAS float*)(lds + L_IMPS); LAS float* impp = (LAS float*)(lds + L_IMPP);
    bf16x8 qr[4];
#pragma unroll
    for (int d0 = 0; d0 < 4; ++d0) qr[d0] = *(const bf16x8*)(qrow + head * 64 + d0 * 16 + hi * 8);
    f32x16 oacc[2]; oacc[0] = splat(0.f); oacc[1] = splat(0.f); SmState st;
    const bf16* Kc = KC + (size_t)(b * 4 + g) * 128 * 64; const bf16* Vc = VC + (size_t)(b * 4 + g) * 128 * 64;
    const int ncmax = ((64 * qb + 63 - 31) >> 4) + 1, ntc = ncmax > 64 ? 2 : 1;
    const int hlc = (trow - 31) >> 4;
    const int jlo = qb >= 8 ? qb - 8 : 0;
    unsigned sel = 0u, uni = 0u;
    if (tid == 0) misc[0] = 0u;
#pragma unroll 1
    for (int br = 0; br < 3; ++br) {
        const bf16* Kg = (br == 0) ? Kc : QKV + (br == 1 ? NSA_KS : NSA_KW) + g * 64; const bf16* Vg = (br == 0) ? Vc : QKV + (br == 1 ? NSA_VS : NSA_VW) + g * 64;
        const int pitch = (br == 0) ? 64 : NNSA_PAD, nt = (br == 0) ? ntc : (br == 1) ? 1 + __popc(uni) : qb - jlo + 1;
        sm_reset(st);
        TileRegs tr = tile_load(Kg, Vg, pitch, (br == 0) ? 0 : rowbase + 64 * qb, w, lane);
        tile_store(lds, 0, tr, tid);
        __syncthreads();
#pragma unroll 1
        for (int idx = 0; idx < nt; ++idx) {
            const bool more = idx + 1 < nt;
            if (more) { const int rn = (br == 0) ? 64 : rowbase + 64 * ((br == 1) ? nth_bit(uni, idx) : qb - idx - 1); tr = tile_load(Kg, Vg, pitch, rn, w, lane); }
            const LAS unsigned char* Ks = lds + L_K + (idx & 1) * SLOTB; const LAS unsigned char* Vs = lds + L_V + (idx & 1) * SLOTB;
            bool bit = true, domask = false; int ll = -1, hl = 63;
            if (br == 0) { domask = true; hl = hlc - 64 * idx; }
            else if (idx == 0) { domask = true; hl = tl; }
            else if (br == 1) { const int j = nth_bit(uni, idx - 1); bit = (sel >> j) & 1u; }
            else if (idx == 8) { domask = true; ll = tl + 1; }
            if (__any(bit)) sm_tile(Ks, Vs, qr, st, bit ? -st.mhat : -INFINITY, idx == 0, domask, ll, hl, wsf, r32, hi, lane);
            if (more) tile_store(lds, (idx & 1) ^ 1, tr, tid);
            __syncthreads();
        }
        const float lt = half_sum(st.l), inv = lt > 0.f ? 1.0f / lt : 0.f;
        const float gate = sigm(bf2f(QKV[(size_t)(rowbase + 64 * qb + 32 * rh + r32) * NNSA_PAD + NSA_G + head * 3 + br]));
        scale_rows<true>(oacc, st.o, gate * inv, wsf, r32, hi);
        if (br == 0) {
            LAS float* pa_ = impp + (size_t)(w * 2 + 0) * 1024 + r32 * 32; LAS float* pb_ = impp + (size_t)(w * 2 + 1) * 1024 + r32 * 32;
            if (hi == 0) pb_[0] = 0.f;
#pragma unroll 1
            for (int T = 0; T < 2; ++T) {
                f32x16 p0, p1;
                if (T < ntc) { const f32x16 c = splat(-st.mhat); qkt(p0, p1, lds + L_K + T * SLOTB, qr, c, r32, hi); cmask(p0, p1, -1, hlc - 64 * T, hi);
#pragma unroll
                    for (int r = 0; r < 16; ++r) { p0[r] = ex2(p0[r]) * inv; p1[r] = ex2(p1[r]) * inv; } }
                else { p0 = splat(0.f); p1 = splat(0.f); }
#pragma unroll
                for (int g4 = 0; g4 < 4; ++g4) {
                    const int j0 = 16 * T + 2 * g4 + hi, j1 = j0 + 8;
                    pa_[j0] = p0[4 * g4] + p0[4 * g4 + 1] + p0[4 * g4 + 2] + 0.5f * p0[4 * g4 + 3]; if (j0 + 1 < 32) pb_[j0 + 1] = 0.5f * p0[4 * g4 + 3];
                    pa_[j1] = p1[4 * g4] + p1[4 * g4 + 1] + p1[4 * g4 + 2] + 0.5f * p1[4 * g4 + 3]; if (j1 + 1 < 32) pb_[j1 + 1] = 0.5f * p1[4 * g4 + 3];
                }
            }
            __syncthreads();
            if (qb >= 16) {
                const int row = tid >> 3, jq = tid & 7, rr = row >> 5, q = row & 31;
#pragma unroll
                for (int e = 0; e < 4; ++e) { const int j = 4 * jq + e; float s_ = 0.f;
#pragma unroll
                    for (int h2 = 0; h2 < 4; ++h2) { const int ww = 2 * h2 + rr; s_ += impp[(size_t)(ww * 2 + 0) * 1024 + q * 32 + j] + impp[(size_t)(ww * 2 + 1) * 1024 + q * 32 + j]; }
                    imps[row * 32 + j] = s_; }
                __syncthreads();
                unsigned bits = 0u;
#pragma unroll 1
                for (int e = 0; e < 4; ++e) { const int j = 4 * jq + e; const float vj = imps[row * 32 + j]; int rank = 0;
                    for (int jp = 1; jp <= qb - 2; ++jp) { const float vp = imps[row * 32 + jp]; rank += ((vp > vj) || (vp == vj && jp < j)) ? 1 : 0; }
                    const bool forced = (j == 0) || (j == qb) || (j == qb - 1), cand = (j >= 1) && (j <= qb - 2);
                    if (forced || (cand && rank < 13)) bits |= 1u << j; }
                bits |= __shfl_xor(bits, 1); bits |= __shfl_xor(bits, 2); bits |= __shfl_xor(bits, 4);
                if (jq == 0) selm[row] = bits;
                __syncthreads();
            }
            sel = (qb >= 16) ? selm[tl] : ((qb == 31) ? 0xffffffffu : ((1u << (qb + 1)) - 1u));
            { unsigned wsel = 0u;
              for (int j = 0; j <= qb; ++j) if (__any((sel >> j) & 1u)) wsel |= 1u << j;
              if (lane == 0) __hip_atomic_fetch_or(misc, wsel, __ATOMIC_RELAXED, __HIP_MEMORY_SCOPE_WORKGROUP); }
            __syncthreads();
            uni = misc[0] & ~(1u << qb);
        }
    }
    store_rows(oacc, O + (size_t)(rowbase + 64 * qb + 32 * rh) * DM + head * 64, lds, w, lane, r32, hi);
    __syncthreads();
}

__device__ __forceinline__ float gelu_t(float x) { const float u = 0.7978845608028654f * (x + 0.044715f * x * x * x); const float e = __expf(2.0f * u); return 0.5f * x * (1.0f + (e - 1.0f) / (e + 1.0f)); }
__device__ __forceinline__ void compress_unit(LAS unsigned char* lds, const bf16* QKV, const bf16* W1t, const bf16* W2t, const float* bias, bf16* OUT, int kv, int bg, int cb, int tid) {
    const int lane = tid & 63, w = __builtin_amdgcn_readfirstlane(tid >> 6), r32 = lane & 31, hi = lane >> 5;
    const int b = bg >> 2, g = bg & 3, colbase = (kv ? NSA_VC : NSA_KC) + g * 64, c = 32 * cb + r32;
    LAS bf16* hid = (LAS bf16*)lds;
    f32x16 acc = splat(0.f);
    const bf16* wrow = W1t + (size_t)(32 * w + r32) * 2048 + hi * 8;
    for (int l = 0; l < 32; ++l) {
        int rowi = 16 * c + l; rowi = rowi < SEQ ? rowi : SEQ - 1;
        const bf16* arow = QKV + (size_t)(b * SEQ + rowi) * NNSA_PAD + colbase + hi * 8;
#pragma unroll
        for (int s4 = 0; s4 < 4; ++s4) {
            const bf16x8 af = *(const bf16x8*)(arow + 16 * s4), bfr = *(const bf16x8*)(wrow + l * 64 + 16 * s4);
            acc = __builtin_amdgcn_mfma_f32_32x32x16_bf16(af, bfr, acc, 0, 0, 0);
        }
    }
    { const float bv = bias[32 * w + r32];
#pragma unroll
      for (int r = 0; r < 16; ++r) hid[crow(r, hi) * 264 + 32 * w + r32] = (bf16)f2bf(gelu_t(acc[r] + bv)); }
    __syncthreads();
    if (w < 2) {
        f32x16 o = splat(0.f);
        const bf16* w2row = W2t + (size_t)(32 * w + r32) * 256 + hi * 8;
#pragma unroll
        for (int s = 0; s < 16; ++s) {
            const bf16x8 af = *(const LAS bf16x8*)(hid + r32 * 264 + 16 * s + hi * 8), bfr = *(const bf16x8*)(w2row + 16 * s);
            o = __builtin_amdgcn_mfma_f32_32x32x16_bf16(af, bfr, o, 0, 0, 0);
        }
#pragma unroll
        for (int r = 0; r < 16; ++r) { const int cc = 32 * cb + crow(r, hi); OUT[(size_t)(bg * 128 + cc) * 64 + 32 * w + r32] = (cc == 127) ? (bf16)0 : (bf16)f2bf(o[r]); }
    }
    __syncthreads();
}
}

__device__ __forceinline__ void phase_sb_fast(Frame& F) {
    const bf16* QKV = (const bf16*)(F.ws + WS_QKV); bf16* O = (bf16*)(F.ws + WS_O);
    const int bx = blockIdx.x, vcu = (F.G == 256) ? (bx & 7) * 32 + (bx >> 3) : bx;
    for (int u = vcu; u < BATCH * NH * 8; u += F.G) { const int uu = (F.G == 256) ? (vcu * 4 + (u >> 8)) : u; fa::sb_unit(F.lds, QKV, O, (uu >> 3) >> 4, (uu >> 3) & 15, uu & 7, F.tid); }
}
__device__ __forceinline__ void phase_nsa_fast(Frame& F) {
    const bf16* QKV = (const bf16*)(F.ws + WS_QKV); bf16* O = (bf16*)(F.ws + WS_O);
    const bf16* KC = (const bf16*)(F.ws + WS_KCMP); const bf16* VC = (const bf16*)(F.ws + WS_VCMP);
    const int bx = blockIdx.x, vcu = (bx & 7) * 32 + (bx >> 3), bal = (F.G == 256);
    const int nun = bal ? 4 : (32 * 32 - bx + F.G - 1) / F.G;
#pragma unroll 1
    for (int i = 0; i < nun; ++i) {
        int bg, qb;
        if (bal) { const int s = vcu & 7; bg = vcu >> 3; qb = (i == 0) ? s : (i == 1) ? 15 - s : (i == 2) ? 16 + s : 31 - s; }
        else { const int u = bx + i * F.G; bg = u >> 5; qb = u & 31; }
        int t_ = threadIdx.x; asm volatile("" : "+v"(t_));
        fa::nsa_unit(F.lds, QKV, KC, VC, O, bg >> 2, bg & 3, qb, t_);
    }
}
__device__ __forceinline__ void phase_compress_fast(Frame& F, int L) {
    const bf16* QKV = (const bf16*)(F.ws + WS_QKV); unsigned char* wb = F.ws + WS_W + (size_t)(L & 1) * W_BUF; const float* bias = (const float*)(F.ws + WS_BIAS);
    for (int u = blockIdx.x; u < 2 * 32 * 4; u += F.G) { const int kv = u >> 7, bg = (u >> 2) & 31, cb = u & 3;
        fa::compress_unit(F.lds, QKV, (const bf16*)(wb + (kv ? W_1V : W_1K)), (const bf16*)(wb + (kv ? W_2V : W_2K)), bias + kv * 256, (bf16*)(F.ws + (kv ? WS_VCMP : WS_KCMP)), kv, bg, cb, F.tid); }
}

__device__ __forceinline__ bool phase_active(int ph) { const int L = ph / NPH, p = ph % NPH, kind = L % 3; return !(p == 3 && kind == 1); }

__global__ void __launch_bounds__(NTHREADS, 2) mk_fwd(Args a) {
    extern __shared__ __attribute__((aligned(16))) unsigned char lds[];
    Frame F;
    F.lds = (LAS unsigned char*)lds; F.tid = threadIdx.x; F.lane = F.tid & 63; F.wave = __builtin_amdgcn_readfirstlane(F.tid >> 6);
    F.G = gridDim.x; F.gw = blockIdx.x * NWAVES + F.wave; F.ngw = F.G * NWAVES; F.ws = a.ws; F.xres = a.out;
    if (F.tid < 39) ((LAS unsigned long long*)(F.lds + PTAB_OFF))[F.tid] = (unsigned long long)a.in[F.tid];
    __syncthreads();
    for (int ph = a.ph_lo; ph < a.ph_hi; ++ph) {
        if (!phase_active(ph)) continue;
        { int t_ = threadIdx.x; asm volatile("" : "+v"(t_)); F.tid = t_; F.lane = t_ & 63; F.wave = __builtin_amdgcn_readfirstlane(t_ >> 6); F.gw = blockIdx.x * NWAVES + F.wave; }
        const int L = ph / NPH, p = ph % NPH, kind = L % 3;
        unsigned char* wb = F.ws + WS_W + (size_t)(L & 1) * W_BUF;
        if (p == 0) phase_conv(F, L);
        else if (p == 1) { const int np = (kind == 2) ? NNSA_PAD : NQKV;
            pg8::Gemm g{(const bf16*)(F.ws + WS_XN), (const bf16*)(wb + W_IN), M, np, DM}; pg8::EpiBf16 E{(bf16*)(F.ws + WS_QKV), np, 0};
            pg8::StaticOrder S; S.init(M, np, F.G, (int)blockIdx.x);
            pg8::gemm_phase<pg8::EpiBf16, pg8::StaticOrder, true, true>(F.lds, g, S, E, F.tid); }
        else if (p == 5) {
            pg8::Gemm g{(const bf16*)(F.ws + WS_O), (const bf16*)(wb + W_OUT), M, DM, DM}; pg8::EpiBf16 E{(bf16*)(F.ws + WS_XN), DM, 0};
            pg8::StaticOrder S; S.init(M, DM, F.G, (int)blockIdx.x);
            pg8::gemm_phase<pg8::EpiBf16, pg8::StaticOrder, true, true>(F.lds, g, S, E, F.tid); }
        else if (p == 7) {
            pg8::Gemm g{(const bf16*)(F.ws + WS_XN), (const bf16*)(wb + W_UP), M, FF, DM}; pg8::EpiBf16 E{(bf16*)(F.ws + WS_H), FF, 1};
            pg8::StaticOrder S; S.init(M, FF, F.G, (int)blockIdx.x);
            pg8::gemm_phase<pg8::EpiBf16, pg8::StaticOrder, true, true>(F.lds, g, S, E, F.tid); }
        else if (p == 8) {
            pg8::Gemm g{(const bf16*)(F.ws + WS_H), (const bf16*)(wb + W_DOWN), M, DM, FF}; pg8::EpiBf16 E{(bf16*)(F.ws + WS_XN), DM, 0};
            pg8::StaticOrder S; S.init(M, DM, F.G, (int)blockIdx.x);
            pg8::gemm_phase<pg8::EpiBf16, pg8::StaticOrder, true, true>(F.lds, g, S, E, F.tid); }
        else if (p == 2) phase_rope(F, kind);
        else if (p == 3) { if (kind == 0) phase_ksum(F); else { phase_compress_fast(F, L); } }
        else if (p == 4) { if (kind == 0) phase_moba_fast(F); else if (kind == 1) phase_sb_fast(F); else phase_nsa_fast(F); }
        else { const LayerPtrs P = layer_ptrs(F.lds, L); const float* gnext = (L + 1 < NLAYER) ? layer_ptrs(F.lds, L + 1).g_pre : nullptr;
            if (p == 6) phase_norm(F, P.g_post, P.g_mlp_pre); else phase_norm(F, P.g_mlp_post, gnext); }
        if (ph + 1 < a.ph_hi) cooperative_groups::this_grid().sync();
    }
}

extern "C" void kernel_launch(void* const* d_in, const int* in_sizes, int n_in, void* d_out, int out_size, void* d_ws, size_t ws_size, hipStream_t stream) {
    static int grid = 0;
    if (grid == 0) {
        if (n_in != 39 || in_sizes[0] != M * DM || out_size != M * DM || ws_size < WS_END) { fprintf(stderr, "kernel_launch: unexpected problem shape (n_in %d, ws %zu)\n", n_in, ws_size); grid = -1; return; }
        int dev = 0, cus = 0;
        if (hipGetDevice(&dev) != hipSuccess || hipDeviceGetAttribute(&cus, hipDeviceAttributeMultiprocessorCount, dev) != hipSuccess) { grid = -1; return; }
        if (hipFuncSetAttribute((const void*)mk_fwd, hipFuncAttributeMaxDynamicSharedMemorySize, LDS_BYTES) != hipSuccess) { fprintf(stderr, "kernel_launch: hipFuncSetAttribute failed\n"); grid = -1; return; }
        int per_cu = 0;
        if (hipOccupancyMaxActiveBlocksPerMultiprocessor(&per_cu, (const void*)mk_fwd, NTHREADS, LDS_BYTES) != hipSuccess || per_cu < 1) { fprintf(stderr, "kernel_launch: occupancy query failed (%d)\n", per_cu); grid = -1; return; }
        grid = cus;
    }
    if (grid < 0) return;
    Args a{};
    for (int i = 0; i < 39; ++i) a.in[i] = (const float*)d_in[i];
    a.out = (float*)d_out; a.ws = (unsigned char*)d_ws; a.ph_lo = 0; a.ph_hi = NLAYER * NPH;
    void* kargs[] = {&a};
    const hipError_t e = hipLaunchCooperativeKernel((const void*)mk_fwd, dim3(grid), dim3(NTHREADS), kargs, LDS_BYTES, stream);
    if (e != hipSuccess) fprintf(stderr, "kernel_launch: cooperative launch failed: %s (grid %d)\n", hipGetErrorString(e), grid);
}
```
